# Optimizing an MI355X kernel written in HIP

```python
import math
import jax
import jax.numpy as jnp
from jax import lax
import numpy as np

D_MODEL = 1024
BATCH = 2
SEQ = 8192
DEPTH = 2

GRID_W = 64
CTX_LEN = 256
HEAD_DIM = 64
ROPE_THETA = 10000.0
EPS = 1e-6
N_SUB = 3
N_MOD = 3 * N_SUB
D_FF = 2816
S5_WIDTH = D_MODEL // 2
S5_GROUP = 16
S5_GROUPS = S5_WIDTH // S5_GROUP
S5_STATE = 64
S5_MIN_STEP = 1e-3
S5_MAX_STEP = 1e-1
GA_HEADS = (D_MODEL // 2) // HEAD_DIM
GA_KV = GA_HEADS // 4
AB_IN = S5_WIDTH + (GA_HEADS + 2 * GA_KV) * HEAD_DIM
Q_BLOCK = 128
WIN_HEADS = D_MODEL // HEAD_DIM
WIN_KV = WIN_HEADS // 4
WINDOW = 128
WIN_BLOCK = 128
WIN_IN = (WIN_HEADS + 2 * WIN_KV) * HEAD_DIM
N_EVEN = (DEPTH + 1) // 2
N_ODD = DEPTH // 2

kernel_name = 'hybrid_s5_gqa_swa_macaron_dit'


def rms_norm(x, g):
    xf = x.astype(jnp.float32)
    y = xf * lax.rsqrt(jnp.mean(xf * xf, axis=-1, keepdims=True) + EPS)
    return (y * g.astype(jnp.float32)).astype(x.dtype)


def ada_in(h, gain, m, s):
    return rms_norm(h, gain) * (1 + m[:, :, 3 * s + 1]) + m[:, :, 3 * s]


def ada_gate(m, s):
    return m[:, :, 3 * s + 2]


def swiglu(h, wg, wu, wd):
    return (jax.nn.silu(h @ wg) * (h @ wu)) @ wd


def axial_rope(rows):
    r = jnp.repeat(jnp.arange(rows, dtype=jnp.float32), GRID_W)
    col = jnp.tile(jnp.arange(GRID_W, dtype=jnp.float32), rows)
    n_freq = HEAD_DIM // 4
    inv = ROPE_THETA ** (-jnp.arange(n_freq, dtype=jnp.float32) / n_freq)
    ang = jnp.concatenate([r[:, None] * inv, col[:, None] * inv], axis=-1)
    return jnp.cos(ang), jnp.sin(ang)


def apply_rope(x, cos, sin):
    half = HEAD_DIM // 2
    cs = cos[None, :, None, :].astype(x.dtype)
    sn = sin[None, :, None, :].astype(x.dtype)
    x1, x2 = x[..., :half], x[..., half:]
    return jnp.concatenate([x1 * cs - x2 * sn, x1 * sn + x2 * cs], axis=-1)


def split_heads(t, n):
    return t.reshape(t.shape[0], t.shape[1], n, HEAD_DIM)


def gqa_scores(q5, k):
    s = jnp.einsum('bqkgd,bskd->bkgqs', q5, k, preferred_element_type=jnp.float32)
    return s * (HEAD_DIM ** -0.5)


def gqa_values(p, v):
    return jnp.einsum('bkgqs,bskd->bqkgd', p.astype(v.dtype), v)


def sink_softmax(s, sink):
    sk = jnp.broadcast_to(sink.astype(jnp.float32)[:, :, None, None], s.shape[:-1] + (1,))
    p = jax.nn.softmax(jnp.concatenate([s, sk], axis=-1), axis=-1)
    return p[..., :-1]


def attend_full(q, k, v, sink=None):
    b, nq, h, d = q.shape
    hkv = k.shape[2]
    s = gqa_scores(q.reshape(b, nq, hkv, h // hkv, d), k)
    p = jax.nn.softmax(s, axis=-1) if sink is None else sink_softmax(s, sink)
    return gqa_values(p, v).reshape(b, nq, h * d)


def dense_gqa(q, k, v, kc, vc):
    b, n, h, d = q.shape
    hkv = k.shape[2]
    nb = n // Q_BLOCK
    k_all = jnp.concatenate([kc, k], axis=1)
    v_all = jnp.concatenate([vc, v], axis=1)
    qb = q.reshape(b, nb, Q_BLOCK, hkv, h // hkv, d).transpose(1, 0, 2, 3, 4, 5)

    def block(qi):
        p = jax.nn.softmax(gqa_scores(qi, k_all), axis=-1)
        return gqa_values(p, v_all)

    o = lax.map(block, qb)
    return o.transpose(1, 0, 2, 3, 4, 5).reshape(b, n, h * d)


def window_gqa(q, k, v, kc, vc, sink):
    b, n, h, d = q.shape
    hkv = k.shape[2]
    nb = n // WIN_BLOCK
    span = 3 * WIN_BLOCK

    def bands(t):
        tp = jnp.pad(t, ((0, 0), (WIN_BLOCK, WIN_BLOCK), (0, 0), (0, 0)))
        parts = [tp[:, o * WIN_BLOCK:o * WIN_BLOCK + n].reshape(b, nb, WIN_BLOCK, hkv, d) for o in range(3)]
        return jnp.concatenate(parts, axis=2).transpose(1, 0, 2, 3, 4)

    kb, vb = bands(k), bands(v)
    qb = q.reshape(b, nb, WIN_BLOCK, hkv, h // hkv, d).transpose(1, 0, 2, 3, 4, 5)
    qpos = jnp.arange(nb)[:, None, None] * WIN_BLOCK + jnp.arange(WIN_BLOCK)[None, :, None]
    kpos = jnp.arange(nb)[:, None, None] * WIN_BLOCK - WIN_BLOCK + jnp.arange(span)[None, None, :]
    valid = (kpos >= 0) & (kpos < n) & (jnp.abs(kpos - qpos) <= WINDOW)

    def block(args):
        qi, ki, vi, mi = args
        s_loc = jnp.where(mi, gqa_scores(qi, ki), -jnp.inf)
        s_ctx = gqa_scores(qi, kc)
        p = sink_softmax(jnp.concatenate([s_loc, s_ctx], axis=-1), sink)
        return gqa_values(p[..., :span], vi) + gqa_values(p[..., span:], vc)

    o = lax.map(block, (qb, kb, vb, valid))
    return o.transpose(1, 0, 2, 3, 4, 5).reshape(b, n, h * d)


def _lin_rec(e1, e2):
    a1, b1 = e1
    a2, b2 = e2
    return a1 * a2, a2 * b1 + b2


def s5_direction(u_ctx, u_lat, lam_re, lam_im, b_re, b_im, c_re, c_im, log_step, reverse, need_ctx_out):
    lam = lax.complex(jnp.minimum(lam_re.astype(jnp.float32), -1e-4), lam_im.astype(jnp.float32))
    dt = jnp.exp(log_step.astype(jnp.float32))[:, None]
    lam_bar = jnp.exp(lam * dt)
    b_bar = ((lam_bar - 1) / lam)[..., None] * lax.complex(b_re.astype(jnp.float32), b_im.astype(jnp.float32))
    c_mat = lax.complex(c_re.astype(jnp.float32), c_im.astype(jnp.float32))

    def run(u, h0):
        nb_, n = u.shape[0], u.shape[1]
        ug = u.astype(jnp.float32).reshape(nb_, n, S5_GROUPS, S5_GROUP).astype(jnp.complex64)
        bu = jnp.einsum('blgh,gph->blgp', ug, b_bar)
        first, last = (n - 1, 0) if reverse else (0, n - 1)
        if h0 is not None:
            bu = bu.at[:, first].add(lam_bar * h0)
        a = jnp.broadcast_to(lam_bar, bu.shape)
        _, hs = lax.associative_scan(_lin_rec, (a, bu), reverse=reverse, axis=1)
        return hs, hs[:, last]

    def read(hs, like):
        y = jnp.einsum('blgp,ghp->blgh', hs, c_mat).real
        return y.reshape(like.shape).astype(like.dtype)

    h_ctx, h_ctx_final = run(u_ctx, None)
    h_lat, _ = run(u_lat, h_ctx_final)
    y_ctx = read(h_ctx, u_ctx) if need_ctx_out else None
    return read(h_lat, u_lat), y_ctx


def s5_glu(y, glu_w):
    g = jax.nn.gelu(y)
    return (g @ glu_w[0]) * jax.nn.sigmoid(g @ glu_w[1])


def mixer_ab(hx, hc, cos, sin, w_in, w_out, qk_g, lam_re, lam_im, b_re, b_im, c_re, c_im,
             log_step, d_skip, glu_w, need_ctx_out):
    qw, kw = GA_HEADS * HEAD_DIM, GA_KV * HEAD_DIM
    z = hx @ w_in
    u, q, k, v = jnp.split(z, [S5_WIDTH, S5_WIDTH + qw, S5_WIDTH + qw + kw], axis=-1)
    uc = hc @ w_in[:, :S5_WIDTH]
    kc, vc = jnp.split(hc @ w_in[:, S5_WIDTH + qw:], [kw], axis=-1)
    y_lat = d_skip * u
    y_ctx = d_skip * uc if need_ctx_out else None
    for r in range(2):
        yl, yc = s5_direction(uc, u, lam_re[r], lam_im[r], b_re[r], b_im[r], c_re[r], c_im[r],
                              log_step[r], r == 1, need_ctx_out)
        y_lat = y_lat + yl
        if need_ctx_out:
            y_ctx = y_ctx + yc
    qn = apply_rope(rms_norm(split_heads(q, GA_HEADS), qk_g[0]), cos, sin)
    kn = apply_rope(rms_norm(split_heads(k, GA_KV), qk_g[1]), cos, sin)
    kcn = rms_norm(split_heads(kc, GA_KV), qk_g[1])
    vch = split_heads(vc, GA_KV)
    b_lat = dense_gqa(qn, kn, split_heads(v, GA_KV), kcn, vch)
    out_lat = jnp.concatenate([s5_glu(y_lat, glu_w), b_lat], axis=-1) @ w_out
    if not need_ctx_out:
        return out_lat, None
    qc = rms_norm(split_heads(hc @ w_in[:, S5_WIDTH:S5_WIDTH + qw], GA_HEADS), qk_g[0])
    b_ctx = attend_full(qc, kcn, vch)
    out_ctx = jnp.concatenate([s5_glu(y_ctx, glu_w), b_ctx], axis=-1) @ w_out
    return out_lat, out_ctx


def mixer_win(hx, hc, cos, sin, w_in, w_out, qk_g, sink, need_ctx_out):
    qw, kw = WIN_HEADS * HEAD_DIM, WIN_KV * HEAD_DIM
    sink = sink.reshape(WIN_KV, WIN_HEADS // WIN_KV)
    q, k, v = jnp.split(hx @ w_in, [qw, qw + kw], axis=-1)
    kc, vc = jnp.split(hc @ w_in[:, qw:], [kw], axis=-1)
    qn = apply_rope(rms_norm(split_heads(q, WIN_HEADS), qk_g[0]), cos, sin)
    kn = apply_rope(rms_norm(split_heads(k, WIN_KV), qk_g[1]), cos, sin)
    kcn = rms_norm(split_heads(kc, WIN_KV), qk_g[1])
    vch = split_heads(vc, WIN_KV)
    out_lat = window_gqa(qn, kn, split_heads(v, WIN_KV), kcn, vch, sink) @ w_out
    if not need_ctx_out:
        return out_lat, None
    qc = rms_norm(split_heads(hc @ w_in[:, :qw], WIN_HEADS), qk_g[0])
    return out_lat, attend_full(qc, kcn, vch, sink) @ w_out


def setup_inputs(seed: int = 0) -> dict:
    key = jax.random.key(seed)
    ks = iter(jax.random.split(key, 32))
    f32 = jnp.float32

    def nrm(shape, scale):
        return scale * jax.random.normal(next(ks), shape, f32)

    d = D_MODEL
    g, p, hh = S5_GROUPS, S5_STATE, S5_GROUP
    return {
        'x': nrm((BATCH, SEQ, d), 1.0),
        'c': nrm((BATCH, d), 1.0),
        'ctx': nrm((BATCH, CTX_LEN, d), 1.0),
        'c_ctx': nrm((d,), 1.0),
        'mod_w': nrm((DEPTH, d, N_MOD * d), 0.5 * d ** -0.5),
        'mod_b': nrm((DEPTH, N_MOD * d), 0.01),
        'norm_g': 1.0 + nrm((DEPTH, N_SUB, d), 0.02),
        'ffn_wg': nrm((DEPTH, 2, d, D_FF), d ** -0.5),
        'ffn_wu': nrm((DEPTH, 2, d, D_FF), d ** -0.5),
        'ffn_wd': nrm((DEPTH, 2, D_FF, d), D_FF ** -0.5),
        'w_out': nrm((DEPTH, d, d), d ** -0.5),
        'qk_norm': 1.0 + nrm((DEPTH, 2, HEAD_DIM), 0.02),
        'ab_w_in': nrm((N_EVEN, d, AB_IN), d ** -0.5),
        's5_lam_re': -0.5 + nrm((N_EVEN, 2, g, p), 0.01),
        's5_lam_im': jnp.pi * jnp.arange(p, dtype=f32) + nrm((N_EVEN, 2, g, p), 0.01),
        's5_b_re': nrm((N_EVEN, 2, g, p, hh), (2 * hh) ** -0.5),
        's5_b_im': nrm((N_EVEN, 2, g, p, hh), (2 * hh) ** -0.5),
        's5_c_re': nrm((N_EVEN, 2, g, hh, p), p ** -0.5),
        's5_c_im': nrm((N_EVEN, 2, g, hh, p), p ** -0.5),
        's5_log_step': jax.random.uniform(next(ks), (N_EVEN, 2, g), f32,
                                          math.log(S5_MIN_STEP), math.log(S5_MAX_STEP)),
        's5_d': nrm((N_EVEN, S5_WIDTH), 1.0),
        's5_glu_w': nrm((N_EVEN, 2, S5_WIDTH, S5_WIDTH), S5_WIDTH ** -0.5),
        'win_w_in': nrm((N_ODD, d, WIN_IN), d ** -0.5),
        'win_sink': nrm((N_ODD, WIN_HEADS), 0.5),
    }


def reference(x, c, ctx, c_ctx, mod_w, mod_b, norm_g, ffn_wg, ffn_wu, ffn_wd, w_out, qk_norm,
              ab_w_in, s5_lam_re, s5_lam_im, s5_b_re, s5_b_im, s5_c_re, s5_c_im, s5_log_step,
              s5_d, s5_glu_w, win_w_in, win_sink):
    batch, n_tok, d = x.shape
    rows = n_tok // GRID_W
    cos, sin = axial_rope(rows)
    xc = ctx
    for l in range(DEPTH):
        last = l == DEPTH - 1
        mx = (jax.nn.silu(c) @ mod_w[l] + mod_b[l]).reshape(batch, 1, N_MOD, d)
        mc = (jax.nn.silu(c_ctx) @ mod_w[l] + mod_b[l]).reshape(1, 1, N_MOD, d)
        x = x + 0.5 * ada_gate(mx, 0) * swiglu(ada_in(x, norm_g[l, 0], mx, 0), ffn_wg[l, 0], ffn_wu[l, 0], ffn_wd[l, 0])
        xc = xc + 0.5 * ada_gate(mc, 0) * swiglu(ada_in(xc, norm_g[l, 0], mc, 0), ffn_wg[l, 0], ffn_wu[l, 0], ffn_wd[l, 0])
        hx = ada_in(x, norm_g[l, 1], mx, 1)
        hc = ada_in(xc, norm_g[l, 1], mc, 1)
        if l % 2 == 0:
            e = l // 2
            ox, oc = mixer_ab(hx, hc, cos, sin, ab_w_in[e], w_out[l], qk_norm[l], s5_lam_re[e], s5_lam_im[e],
                              s5_b_re[e], s5_b_im[e], s5_c_re[e], s5_c_im[e], s5_log_step[e], s5_d[e],
                              s5_glu_w[e], not last)
        else:
            o = l // 2
            ox, oc = mixer_win(hx, hc, cos, sin, win_w_in[o], w_out[l], qk_norm[l], win_sink[o], not last)
        x = x + ada_gate(mx, 1) * ox
        x = x + 0.5 * ada_gate(mx, 2) * swiglu(ada_in(x, norm_g[l, 2], mx, 2), ffn_wg[l, 1], ffn_wu[l, 1], ffn_wd[l, 1])
        if not last:
            xc = xc + ada_gate(mc, 1) * oc
            xc = xc + 0.5 * ada_gate(mc, 2) * swiglu(ada_in(xc, norm_g[l, 2], mc, 2), ffn_wg[l, 1], ffn_wu[l, 1], ffn_wd[l, 1])
    return x
```

```cpp
#include <hip/hip_runtime.h>
#include <cstdint>
#include <cstddef>

namespace nv {
constexpr int D = 1024, BATCH = 2, SEQ = 8192, CTX = 256, HD = 64, DFF = 2816;
constexpr int NLAT = BATCH * SEQ, NCTX = BATCH * CTX, MALL = NLAT + NCTX;
constexpr int NMOD = 9 * D;
constexpr float EPS = 1e-6f;

__device__ __forceinline__ float wave_sum(float v) {
#pragma unroll
    for (int o = 1; o < 64; o <<= 1) v += __shfl_xor(v, o);
    return v;
}
__device__ __forceinline__ float silu_f(float x) { return x / (1.f + __expf(-x)); }
__device__ __forceinline__ int src_of_row(int r) { return r < SEQ ? 0 : (r < NLAT ? 1 : 2); }
__device__ __forceinline__ float* xrow(float* xl, float* xc, int r) { return r < NLAT ? xl + (size_t)r * D : xc + (size_t)(r - NLAT) * D; }

__global__ void k_mod(const float* c, const float* cctx, const float* mod_w, const float* mod_b, float* MOD) {
    const int idx = blockIdx.x * blockDim.x + threadIdx.x;
    if (idx >= 2 * NMOD) return;
    const int l = idx / NMOD, n = idx % NMOD;
    const float* W = mod_w + (size_t)l * D * NMOD;
    float a0 = 0.f, a1 = 0.f, a2 = 0.f;
    for (int k = 0; k < D; ++k) {
        const float w = W[(size_t)k * NMOD + n];
        a0 += silu_f(c[k]) * w; a1 += silu_f(c[D + k]) * w; a2 += silu_f(cctx[k]) * w;
    }
    const float b = mod_b[l * NMOD + n];
    MOD[((size_t)l * 3 + 0) * NMOD + n] = a0 + b;
    MOD[((size_t)l * 3 + 1) * NMOD + n] = a1 + b;
    MOD[((size_t)l * 3 + 2) * NMOD + n] = a2 + b;
}

__global__ void k_norm(float* xl, float* xc, const float* g, const float* MODl, int s, float* HN, int nrows) {
    const int w = (blockIdx.x * blockDim.x + threadIdx.x) >> 6, lane = threadIdx.x & 63;
    if (w >= nrows) return;
    const float* x = xrow(xl, xc, w);
    const float* m = MODl + (size_t)src_of_row(w) * NMOD;
    float v[16]; float ss = 0.f;
#pragma unroll
    for (int j = 0; j < 16; ++j) { v[j] = x[lane + 64 * j]; ss += v[j] * v[j]; }
    const float rs = rsqrtf(wave_sum(ss) * (1.f / D) + EPS);
#pragma unroll
    for (int j = 0; j < 16; ++j) { const int cidx = lane + 64 * j;
        HN[(size_t)w * D + cidx] = v[j] * rs * g[cidx] * (1.f + m[(3 * s + 1) * D + cidx]) + m[(3 * s) * D + cidx]; }
}

struct GP { const float* A; int lda; const float* B; const float* B2; int ldb; float* C; int ldc; int M, N, K;
            float* xl; float* xc; const float* MODl; int gate_row; float coef; };
template <int MODE> __global__ void __launch_bounds__(256) k_gemm(GP p) {
    __shared__ float As[16][64 + 4], Bs[16][64 + 4], Bs2[(MODE == 1 || MODE == 3) ? 16 : 1][64 + 4];
    const int tid = threadIdx.x, tx = tid & 15, ty = tid >> 4;
    const int m0 = blockIdx.y * 64, n0 = blockIdx.x * 64;
    float acc[4][4] = {}, acc2[4][4] = {};
    for (int k0 = 0; k0 < p.K; k0 += 16) {
        { const int r = tid >> 2, c4 = (tid & 3) * 4;
            const float4 a = *(const float4*)(p.A + (size_t)(m0 + r) * p.lda + k0 + c4);
            As[c4 + 0][r] = a.x; As[c4 + 1][r] = a.y; As[c4 + 2][r] = a.z; As[c4 + 3][r] = a.w; }
        { const int r = tid >> 4, c4 = (tid & 15) * 4;
            *(float4*)&Bs[r][c4] = *(const float4*)(p.B + (size_t)(k0 + r) * p.ldb + n0 + c4);
            if (MODE == 1 || MODE == 3) *(float4*)&Bs2[r][c4] = *(const float4*)(p.B2 + (size_t)(k0 + r) * p.ldb + n0 + c4); }
        __syncthreads();
#pragma unroll
        for (int kk = 0; kk < 16; ++kk) {
            float a[4], b[4], b2[4];
#pragma unroll
            for (int i = 0; i < 4; ++i) { a[i] = As[kk][ty * 4 + i]; b[i] = Bs[kk][tx * 4 + i]; if (MODE == 1 || MODE == 3) b2[i] = Bs2[kk][tx * 4 + i]; }
#pragma unroll
            for (int i = 0; i < 4; ++i)
#pragma unroll
                for (int j = 0; j < 4; ++j) { acc[i][j] += a[i] * b[j]; if (MODE == 1 || MODE == 3) acc2[i][j] += a[i] * b2[j]; }
        }
        __syncthreads();
    }
#pragma unroll
    for (int i = 0; i < 4; ++i) { const int r = m0 + ty * 4 + i;
#pragma unroll
        for (int j = 0; j < 4; ++j) { const int c = n0 + tx * 4 + j;
            if (MODE == 0) p.C[(size_t)r * p.ldc + c] = acc[i][j];
            if (MODE == 1) p.C[(size_t)r * p.ldc + c] = silu_f(acc[i][j]) * acc2[i][j];
            if (MODE == 3) p.C[(size_t)r * p.ldc + c] = acc[i][j] * (1.f / (1.f + __expf(-acc2[i][j])));
            if (MODE == 2) { float* xr = xrow(p.xl, p.xc, r); const float gt = p.MODl[(size_t)src_of_row(r) * NMOD + p.gate_row * D + c]; xr[c] += p.coef * gt * acc[i][j]; }
        } }
}

__global__ void k_qkpost(float* Z, int ldz, int qoff, int nq, int koff, int nk, const float* qk_g  , int nrows) {
    const int w = (blockIdx.x * blockDim.x + threadIdx.x) >> 6, lane = threadIdx.x & 63;
    const int nh = nq + nk; if (w >= nrows * nh) return;
    const int r = w / nh, h = w % nh; const bool isq = h < nq;
    float* p = Z + (size_t)r * ldz + (isq ? qoff + h * HD : koff + (h - nq) * HD);
    const float v = p[lane]; const float rs = rsqrtf(wave_sum(v * v) * (1.f / HD) + EPS);
    const float y = v * rs * qk_g[(isq ? 0 : 1) * HD + lane];
    float out = y;
    if (r < NLAT) {
        const int t = r % SEQ, row = t / 64, col = t % 64; const int j = lane & 31, f = j & 15;
        const float inv = powf(10000.f, -(float)f / 16.f); const float ang = (j < 16 ? (float)row : (float)col) * inv;
        const float cs = cosf(ang), sn = sinf(ang); const float other = __shfl_xor(y, 32);
        out = lane < 32 ? y * cs - other * sn : other * sn + y * cs;
    }
    p[lane] = out;
}

template <int WIN> __global__ void __launch_bounds__(64) k_attn(const float* Z, int ldz, int qoff, int koff, int voff, int nqh, float* O, int ldo, int ooff, const float* sink, int row_lo, int row_hi) {
    const int h = blockIdx.y; const int r = row_lo + blockIdx.x * 64 + threadIdx.x; if (r >= row_hi) return;
    const int kvh = h / 4; const bool lat = r < NLAT; const int b = lat ? r / SEQ : (r - NLAT) / CTX; const int t = lat ? r % SEQ : 0;
    float q[64], o[64];
#pragma unroll
    for (int d = 0; d < 64; ++d) { q[d] = Z[(size_t)r * ldz + qoff + h * HD + d] * 0.125f; o[d] = 0.f; }
    float m = -INFINITY, l = 0.f;
    auto step = [&](int kr) {
        const float* kp = Z + (size_t)kr * ldz + koff + kvh * HD; const float* vp = Z + (size_t)kr * ldz + voff + kvh * HD;
        float s = 0.f;
#pragma unroll
        for (int d = 0; d < 64; ++d) s += q[d] * kp[d];
        const float mn = fmaxf(m, s); const float a = __expf(m - mn), pe = __expf(s - mn);
        l = l * a + pe;
#pragma unroll
        for (int d = 0; d < 64; ++d) o[d] = o[d] * a + pe * vp[d];
        m = mn;
    };
    for (int j = 0; j < CTX; ++j) step(NLAT + b * CTX + j);
    if (lat) {
        if (WIN) { const int lo = t - 128 < 0 ? 0 : t - 128, hi = t + 128 > SEQ - 1 ? SEQ - 1 : t + 128; for (int j = lo; j <= hi; ++j) step(b * SEQ + j); }
        else for (int j = 0; j < SEQ; ++j) step(b * SEQ + j);
    }
    if (sink) { const float s = sink[h]; const float mn = fmaxf(m, s); const float a = __expf(m - mn); l = l * a + __expf(s - mn);
#pragma unroll
        for (int d = 0; d < 64; ++d) o[d] *= a; }
    const float il = 1.f / l;
#pragma unroll
    for (int d = 0; d < 64; ++d) O[(size_t)r * ldo + ooff + h * HD + d] = o[d] * il;
}

__global__ void __launch_bounds__(64) k_s5(const float* Z, int ldz, const float* lam_re, const float* lam_im, const float* b_re, const float* b_im,
                                           const float* c_re, const float* c_im, const float* log_step, float* Y  ) {
    const int p = threadIdx.x; const int g = blockIdx.x % 32, dir = (blockIdx.x / 32) % 2, b = blockIdx.x / 64;
    const int gi = dir * 32 + g;
    const float lre = fminf(lam_re[gi * 64 + p], -1e-4f), lim = lam_im[gi * 64 + p]; const float dt = __expf(log_step[gi]);
    const float er = __expf(lre * dt); float sn, cs; sincosf(lim * dt, &sn, &cs); const float lbr = er * cs, lbi = er * sn;
    const float nr = lbr - 1.f, ni = lbi, den = lre * lre + lim * lim; const float fr = (nr * lre + ni * lim) / den, fi = (ni * lre - nr * lim) / den;
    float br[16], bi[16], cr[16], ci[16];
#pragma unroll
    for (int j = 0; j < 16; ++j) { const float xr = b_re[((size_t)gi * 64 + p) * 16 + j], xi = b_im[((size_t)gi * 64 + p) * 16 + j]; br[j] = fr * xr - fi * xi; bi[j] = fr * xi + fi * xr;
        cr[j] = c_re[((size_t)gi * 16 + j) * 64 + p]; ci[j] = c_im[((size_t)gi * 16 + j) * 64 + p]; }
    float hr = 0.f, hi = 0.f;
    float* Yd = Y + (size_t)dir * MALL * 512;
    const int ntot = CTX + SEQ;
    for (int n = 0; n < ntot; ++n) {
        int row;
        if (dir == 0) row = n < CTX ? NLAT + b * CTX + n : b * SEQ + (n - CTX);
        else row = n < CTX ? NLAT + b * CTX + (CTX - 1 - n) : b * SEQ + (SEQ - 1 - (n - CTX));
        const float* u = Z + (size_t)row * ldz + g * 16;
        float ur = 0.f, ui = 0.f;
#pragma unroll
        for (int j = 0; j < 16; ++j) { const float uj = u[j]; ur += br[j] * uj; ui += bi[j] * uj; }
        const float nhr = lbr * hr - lbi * hi + ur, nhi = lbr * hi + lbi * hr + ui; hr = nhr; hi = nhi;
        float mine = 0.f;
#pragma unroll
        for (int i = 0; i < 16; ++i) { const float y = wave_sum(cr[i] * hr - ci[i] * hi); if (p == i) mine = y; }
        if (p < 16) Yd[(size_t)row * 512 + g * 16 + p] = mine;
    }
}
__global__ void k_s5_comb(const float* Z, int ldz, const float* dskip, const float* Y, float* G, int nrows) {
    const size_t idx = (size_t)blockIdx.x * blockDim.x + threadIdx.x; if (idx >= (size_t)nrows * 512) return;
    const int r = (int)(idx / 512), c = (int)(idx % 512);
    const float y = dskip[c] * Z[(size_t)r * ldz + c] + Y[(size_t)r * 512 + c] + Y[(size_t)MALL * 512 + (size_t)r * 512 + c];
    const float k0 = 0.7978845608028654f; const float in = k0 * (y + 0.044715f * y * y * y);
    G[(size_t)r * 512 + c] = 0.5f * y * (1.f + tanhf(in));
}
}

using namespace nv;
extern "C" void kernel_launch(void* const* d_in, const int* in_sizes, int n_in, void* d_out, int out_size, void* d_ws, size_t ws_size, hipStream_t stream) {
    const float* x = (const float*)d_in[0]; const float* c = (const float*)d_in[1]; const float* ctx = (const float*)d_in[2]; const float* c_ctx = (const float*)d_in[3];
    const float* mod_w = (const float*)d_in[4]; const float* mod_b = (const float*)d_in[5]; const float* norm_g = (const float*)d_in[6];
    const float* ffn_wg = (const float*)d_in[7]; const float* ffn_wu = (const float*)d_in[8]; const float* ffn_wd = (const float*)d_in[9];
    const float* w_out = (const float*)d_in[10]; const float* qk_norm = (const float*)d_in[11]; const float* ab_w_in = (const float*)d_in[12];
    const float* s5_lam_re = (const float*)d_in[13]; const float* s5_lam_im = (const float*)d_in[14]; const float* s5_b_re = (const float*)d_in[15]; const float* s5_b_im = (const float*)d_in[16];
    const float* s5_c_re = (const float*)d_in[17]; const float* s5_c_im = (const float*)d_in[18]; const float* s5_log_step = (const float*)d_in[19];
    const float* s5_d = (const float*)d_in[20]; const float* s5_glu_w = (const float*)d_in[21]; const float* win_w_in = (const float*)d_in[22]; const float* win_sink = (const float*)d_in[23];
    float* xl = (float*)d_out;
    char* ws = (char*)d_ws; size_t off = 0;
    auto carve = [&](size_t bytes) { char* p = ws + off; off += (bytes + 255) & ~(size_t)255; return p; };
    float* MOD = (float*)carve((size_t)2 * 3 * NMOD * 4);
    float* xc = (float*)carve((size_t)NCTX * D * 4);
    float* HN = (float*)carve((size_t)MALL * D * 4);
    char* region = carve(0);
    float* ACT = (float*)region;
    float* CAT = (float*)region;
    float* Z = CAT + (size_t)MALL * 1024;
    float* Y = Z + (size_t)MALL * 1280;
    float* G = HN;
    hipMemcpyAsync(xl, x, (size_t)NLAT * D * 4, hipMemcpyDeviceToDevice, stream);
    hipMemcpyAsync(xc, ctx, (size_t)NCTX * D * 4, hipMemcpyDeviceToDevice, stream);
    k_mod<<<(2 * NMOD + 255) / 256, 256, 0, stream>>>(c, c_ctx, mod_w, mod_b, MOD);
    auto norm = [&](int l, int s, int nrows) { k_norm<<<(nrows * 64 + 255) / 256, 256, 0, stream>>>(xl, xc, norm_g + ((size_t)l * 3 + s) * D, MOD + (size_t)l * 3 * NMOD, s, HN, nrows); };
    auto ffn = [&](int l, int which, int s, int nrows) {
        norm(l, s, nrows);
        const size_t wo = ((size_t)l * 2 + which) * D * DFF;
        GP p{}; p.A = HN; p.lda = D; p.B = ffn_wg + wo; p.B2 = ffn_wu + wo; p.ldb = DFF; p.C = ACT; p.ldc = DFF; p.M = nrows; p.N = DFF; p.K = D;
        k_gemm<1><<<dim3(DFF / 64, nrows / 64), 256, 0, stream>>>(p);
        GP q{}; q.A = ACT; q.lda = DFF; q.B = ffn_wd + wo; q.ldb = D; q.M = nrows; q.N = D; q.K = DFF; q.xl = xl; q.xc = xc; q.MODl = MOD + (size_t)l * 3 * NMOD; q.gate_row = 3 * s + 2; q.coef = 0.5f;
        k_gemm<2><<<dim3(D / 64, nrows / 64), 256, 0, stream>>>(q);
    };
    ffn(0, 0, 0, MALL);
    norm(0, 1, MALL);
    { GP p{}; p.A = HN; p.lda = D; p.B = ab_w_in; p.ldb = 1280; p.C = Z; p.ldc = 1280; p.M = MALL; p.N = 1280; p.K = D;
      k_gemm<0><<<dim3(1280 / 64, MALL / 64), 256, 0, stream>>>(p); }
    k_qkpost<<<(MALL * 10 * 64 + 255) / 256, 256, 0, stream>>>(Z, 1280, 512, 8, 1024, 2, qk_norm, MALL);
    k_attn<0><<<dim3(MALL / 64, 8), 64, 0, stream>>>(Z, 1280, 512, 1024, 1152, 8, CAT, 1024, 512, nullptr, 0, MALL);
    k_s5<<<2 * 2 * 32, 64, 0, stream>>>(Z, 1280, s5_lam_re, s5_lam_im, s5_b_re, s5_b_im, s5_c_re, s5_c_im, s5_log_step, Y);
    k_s5_comb<<<(MALL * 512 + 255) / 256, 256, 0, stream>>>(Z, 1280, s5_d, Y, G, MALL);
    { GP p{}; p.A = G; p.lda = 512; p.B = s5_glu_w; p.B2 = s5_glu_w + 512 * 512; p.ldb = 512; p.C = CAT; p.ldc = 1024; p.M = MALL; p.N = 512; p.K = 512;
      k_gemm<3><<<dim3(512 / 64, MALL / 64), 256, 0, stream>>>(p); }
    { GP q{}; q.A = CAT; q.lda = 1024; q.B = w_out; q.ldb = D; q.M = MALL; q.N = D; q.K = D; q.xl = xl; q.xc = xc; q.MODl = MOD; q.gate_row = 5; q.coef = 1.f;
      k_gemm<2><<<dim3(D / 64, MALL / 64), 256, 0, stream>>>(q); }
    ffn(0, 1, 2, MALL);
    ffn(1, 0, 0, MALL);
    norm(1, 1, MALL);
    { GP p{}; p.A = HN; p.lda = D; p.B = win_w_in; p.ldb = 1536; p.C = Z; p.ldc = 1536; p.M = MALL; p.N = 1536; p.K = D;
      k_gemm<0><<<dim3(1536 / 64, MALL / 64), 256, 0, stream>>>(p); }
    k_qkpost<<<(MALL * 20 * 64 + 255) / 256, 256, 0, stream>>>(Z, 1536, 0, 16, 1024, 4, qk_norm + 2 * 64, MALL);
    k_attn<1><<<dim3(NLAT / 64, 16), 64, 0, stream>>>(Z, 1536, 0, 1024, 1280, 16, CAT, 1024, 0, win_sink, 0, NLAT);
    { GP q{}; q.A = CAT; q.lda = 1024; q.B = w_out + (size_t)D * D; q.ldb = D; q.M = NLAT; q.N = D; q.K = D; q.xl = xl; q.xc = xc; q.MODl = MOD + (size_t)3 * NMOD; q.gate_row = 5; q.coef = 1.f;
      k_gemm<2><<<dim3(D / 64, NLAT / 64), 256, 0, stream>>>(q); }
    ffn(1, 1, 2, NLAT);
}
```

```cpp
#include <hip/hip_runtime.h>
#include <hip/hip_bf16.h>
#include <hip/hip_cooperative_groups.h>
#include <cstdio>
#include <cstdint>
#include <cmath>
#define MK_ONE_LAUNCH 1
namespace pg8 {
#define PG8_LAS __attribute__((address_space(3)))
typedef unsigned short bf16_t;
typedef short bf16x8 __attribute__((ext_vector_type(8)));
typedef float f32x4 __attribute__((ext_vector_type(4)));
typedef float f32x2 __attribute__((ext_vector_type(2)));
typedef unsigned u32x4 __attribute__((ext_vector_type(4)));
constexpr int BM = 256, BK = 64, HALF = 128, HTB = HALF * BK * 2  , STAGE_BYTES = 8 * HTB, NXCD = 8, WGM = 8;

__host__ __device__ __forceinline__ int lds_byte(int r, int c) { const int st = (r >> 4) * 2 + (c >> 5), rr = r & 15, cc = c & 31, ob = rr * 64 + cc * 2; return st * 1024 + (ob ^ (((ob >> 9) & 1) << 5)); }
__host__ __device__ __forceinline__ void stage_rc(int b, int& R, int& C) { const int st = b / 1024, sb = b % 1024, swz = sb ^ (((sb >> 9) & 1) << 5); R = (st >> 1) * 16 + swz / 64; C = (st & 1) * 32 + (swz % 64) / 2; }
__host__ __device__ __forceinline__ int perm32(int rho) { const int n = rho >> 4, i = rho & 15; return 8 * (i >> 2) + 4 * n + (i & 3); }

struct Unit { int pm, pn; };
struct Gemm { const bf16_t* A; const bf16_t* Bt; int lda, ldb, K; };

struct TileOrder {
    int nM, nN, nwg, G, c, pm0;
    __device__ void init(int nM_, int nN_, int G_, int c_, int pm0_) { nM = nM_; nN = nN_; nwg = nM * nN; G = G_; c = c_; pm0 = pm0_; }
    __device__ bool next(int i, Unit& u) const {
        const long L = (long)i * G + c; if (L >= nwg) return false;
        int wgid = (int)L; { const int q = nwg / NXCD, r = nwg % NXCD, xcd = wgid % NXCD, off = wgid / NXCD; wgid = (xcd < r ? xcd * (q + 1) : r * (q + 1) + (xcd - r) * q) + off; }
        const int nig = WGM * nN, gid = wgid / nig, fm = gid * WGM, gsz = (nM - fm) < WGM ? (nM - fm) : WGM;
        u.pm = pm0 + fm + ((wgid % nig) % gsz); u.pn = (wgid % nig) / gsz; return true;
    }
};
struct GroupOrder {
    int nMt, nNt, aStride, G, c;
    __device__ bool next(int i, Unit& u) const {
        const int L = i * G + c, per = nMt * nNt; if (L >= 32 * per) return false;
        const int g = L / per, r = L % per, mt = r / nNt, nt = r % nNt;
        u.pm = g * aStride + mt; u.pn = g * nNt + nt; return true;
    }
};

__device__ __forceinline__ unsigned cvt_pk_bf16(float lo, float hi) { unsigned r; asm volatile("v_cvt_pk_bf16_f32 %0, %1, %2" : "=v"(r) : "v"(lo), "v"(hi)); return r; }
__device__ __forceinline__ float fast_sigmoid(float x) { return __builtin_amdgcn_rcpf(1.f + __builtin_amdgcn_exp2f(-1.4426950408889634f * x)); }
__device__ __forceinline__ u32x4 pack8(const f32x4 a, const f32x4 b) { u32x4 w; w.x = cvt_pk_bf16(a[0], a[1]); w.y = cvt_pk_bf16(a[2], a[3]); w.z = cvt_pk_bf16(b[0], b[1]); w.w = cvt_pk_bf16(b[2], b[3]); return w; }

typedef f32x4 Acc[2][2][4][2];

template <class Epi, class Sched, bool ALIGN_EPI>
__device__ __forceinline__ void gemm_phase(PG8_LAS unsigned char* lds, const int tid, const Gemm g, const Sched& S, const Epi& E) {
    const int wid = __builtin_amdgcn_readfirstlane(tid >> 6), lane = tid & 63, wr = wid >> 2, wc = wid & 3, fr = lane & 15, fq = lane >> 4;
    const int K = g.K, nt = K / BK;
    unsigned voffA[2], voffB[2];
#pragma unroll
    for (int i = 0; i < 2; ++i) { int R, C; stage_rc(tid * 16 + i * 8192, R, C); const int Rb = Epi::PERM ? ((R & ~31) + perm32(R & 31)) : R;
        voffA[i] = (unsigned)(R * g.lda + C) * 2u; voffB[i] = (unsigned)(Rb * g.ldb + C) * 2u; }
    const size_t kstep = (size_t)(BK * 2);
    const size_t hstepA = (size_t)HALF * g.lda * 2, hstepB = (size_t)HALF * g.ldb * 2, tstepA = 2 * hstepA, tstepB = 2 * hstepB;
    const unsigned ldsw = (unsigned)wid * 1024u;
    const int aoff = lds_byte(wr * 64 + fr, fq * 8), boff = lds_byte(wc * 32 + fr, fq * 8);
#define PG8_SA(b, h) (((b) * 2 + (h)) * HTB)
#define PG8_SB(b, h) ((4 + (b) * 2 + (h)) * HTB)
#define PG8_STAGE(bufoff, gbase, voff) do { _Pragma("unroll") for (int _i = 0; _i < 2; ++_i) \
        __builtin_amdgcn_global_load_lds((const unsigned*)((const char*)(gbase) + (voff)[_i]), (PG8_LAS unsigned*)(lds + (bufoff) + ldsw + _i * 8192), 16, 0, 0); } while (0)
#define PG8_LDA(dst, b, h) do { _Pragma("unroll") for (int m = 0; m < 4; ++m) _Pragma("unroll") for (int k = 0; k < 2; ++k) dst[m][k] = *(const PG8_LAS bf16x8*)(lds + PG8_SA(b, h) + aoff + m * 2048 + k * 1024); } while (0)
#define PG8_LDB(dst, b, h) do { _Pragma("unroll") for (int n = 0; n < 2; ++n) _Pragma("unroll") for (int k = 0; k < 2; ++k) dst[n][k] = *(const PG8_LAS bf16x8*)(lds + PG8_SB(b, h) + boff + n * 2048 + k * 1024); } while (0)
#define PG8_MMA(ai, bj, At, Bt) do { __builtin_amdgcn_s_setprio(1); _Pragma("unroll") for (int m = 0; m < 4; ++m) _Pragma("unroll") for (int n = 0; n < 2; ++n) _Pragma("unroll") for (int k = 0; k < 2; ++k) \
        acc[ai][bj][m][n] = __builtin_amdgcn_mfma_f32_16x16x32_bf16(Bt[n][k], At[m][k], acc[ai][bj][m][n], 0, 0, 0); __builtin_amdgcn_s_setprio(0); } while (0)
#define PG8_WAIT_V(n) asm volatile("s_waitcnt vmcnt(" #n ")" ::: "memory")
#define PG8_WAIT_L(n) asm volatile("s_waitcnt lgkmcnt(" #n ")" ::: "memory")
#define PG8_BAR __builtin_amdgcn_s_barrier()
#define PG8_SCHED __builtin_amdgcn_sched_barrier(0)
    Unit cur, nxt; int ui = 0;
    if (!S.next(0, cur)) return;
    f32x4 acc[2][2][4][2];
#pragma unroll
    for (int a = 0; a < 2; ++a)
#pragma unroll
        for (int b = 0; b < 2; ++b)
#pragma unroll
            for (int m = 0; m < 4; ++m)
#pragma unroll
                for (int n = 0; n < 2; ++n) acc[a][b][m][n] = (f32x4){0.f, 0.f, 0.f, 0.f};
    bf16x8 At[4][2], B0[2][2], B1[2][2];
    const char* cA = (const char*)g.A + (size_t)cur.pm * tstepA; const char* cB = (const char*)g.Bt + (size_t)cur.pn * tstepB;
    PG8_STAGE(PG8_SB(0, 0), cB, voffB); PG8_STAGE(PG8_SB(0, 1), cB + hstepB, voffB); PG8_STAGE(PG8_SA(0, 0), cA, voffA); PG8_STAGE(PG8_SA(0, 1), cA + hstepA, voffA);
    if (wr == 1) PG8_BAR;
    PG8_WAIT_V(2); PG8_BAR;
    PG8_STAGE(PG8_SB(1, 0), cB + kstep, voffB); PG8_STAGE(PG8_SA(1, 0), cA + kstep, voffA); PG8_STAGE(PG8_SB(1, 1), cB + hstepB + kstep, voffB);
    PG8_WAIT_V(6); PG8_BAR;
    for (;;) {
        const bool has_next = S.next(ui + 1, nxt);
        const char* nA = has_next ? (const char*)g.A + (size_t)nxt.pm * tstepA : cA; const char* nB = has_next ? (const char*)g.Bt + (size_t)nxt.pn * tstepB : cB;
        for (int t = 0; t < nt; t += 2) {
            const bool last = (t == nt - 2);
            const char* a1 = cA + (size_t)(t + 1) * kstep;
            const char* a2 = last ? nA : cA + (size_t)(t + 2) * kstep; const char* b2 = last ? nB : cB + (size_t)(t + 2) * kstep;
            const char* a3 = a2 + kstep; const char* b3 = b2 + kstep;
            PG8_LDB(B0, 0, 0); PG8_LDB(B1, 0, 1); PG8_SCHED; PG8_LDA(At, 0, 0); PG8_STAGE(PG8_SA(1, 1), a1 + hstepA, voffA);
            PG8_WAIT_V(8); PG8_WAIT_L(0); PG8_BAR; PG8_MMA(0, 0, At, B0); PG8_MMA(0, 1, At, B1); PG8_BAR; PG8_SCHED;
            PG8_LDA(At, 0, 1); PG8_STAGE(PG8_SB(0, 0), b2, voffB); PG8_STAGE(PG8_SB(0, 1), b2 + hstepB, voffB); PG8_STAGE(PG8_SA(0, 0), a2, voffA);
            PG8_WAIT_V(8); PG8_WAIT_L(0); PG8_BAR; PG8_MMA(1, 0, At, B0); PG8_MMA(1, 1, At, B1); PG8_BAR; PG8_SCHED;
            PG8_LDB(B0, 1, 0); PG8_LDB(B1, 1, 1); PG8_SCHED; PG8_LDA(At, 1, 0); PG8_STAGE(PG8_SA(0, 1), a2 + hstepA, voffA);
            PG8_WAIT_V(8); PG8_WAIT_L(0); PG8_BAR; PG8_MMA(0, 0, At, B0); PG8_MMA(0, 1, At, B1); PG8_BAR; PG8_SCHED;
            PG8_LDA(At, 1, 1); PG8_STAGE(PG8_SB(1, 0), b3, voffB); PG8_STAGE(PG8_SB(1, 1), b3 + hstepB, voffB); PG8_STAGE(PG8_SA(1, 0), a3, voffA);
            PG8_WAIT_V(8); PG8_WAIT_L(0); PG8_BAR; PG8_MMA(1, 0, At, B0); PG8_MMA(1, 1, At, B1); PG8_BAR; PG8_SCHED;
        }
        if constexpr (ALIGN_EPI) { if (wr == 0) PG8_BAR; }
        E(acc, cur, wr, wc, fr, fq);
        if (!has_next) break;
#pragma unroll
        for (int a = 0; a < 2; ++a)
#pragma unroll
            for (int b = 0; b < 2; ++b)
#pragma unroll
                for (int m = 0; m < 4; ++m)
#pragma unroll
                    for (int n = 0; n < 2; ++n) acc[a][b][m][n] = (f32x4){0.f, 0.f, 0.f, 0.f};
        cur = nxt; cA = nA; cB = nB; ++ui;
        if constexpr (ALIGN_EPI) { if (wr == 1) PG8_BAR; }
    }
    PG8_WAIT_V(0);
    if constexpr (!ALIGN_EPI) { if (wr == 0) PG8_BAR; }
    PG8_BAR;
#undef PG8_SA
#undef PG8_SB
#undef PG8_STAGE
#undef PG8_LDA
#undef PG8_LDB
#undef PG8_MMA
#undef PG8_WAIT_V
#undef PG8_WAIT_L
#undef PG8_BAR
#undef PG8_SCHED
}
}
namespace cfg {
constexpr int D = 1024, BATCH = 2, SEQ = 8192, CTX = 256, HD = 64, DFF = 2816;
constexpr int NLAT = BATCH * SEQ, NCTX = BATCH * CTX, MALL = NLAT + NCTX;
constexpr int NMOD = 9 * D;
constexpr float EPS = 1e-6f;
constexpr int KVROWS = CTX + SEQ;
constexpr int S5T = 32;
constexpr int S5K = S5T * 16 + 256;
constexpr int NCH_LAT = NLAT / S5T, NCH_CTX = NCTX / S5T, NCH = NCH_LAT + NCH_CTX, NCH_PAD = 768;
constexpr float C2 = 0.125f * 1.4426950408889634f;
}

namespace pg8 {
using namespace cfg;
struct EpiSwiglu { static constexpr bool PERM = true; bf16_t* O; int ldo;
    __device__ __forceinline__ void operator()(const Acc& acc, const Unit& u, int wr, int wc, int fr, int fq) const {
        const int row0 = u.pm * BM + wr * 64 + fr, col0 = u.pn * 128 + wc * 32 + 8 * fq;
#pragma unroll
        for (int ai = 0; ai < 2; ++ai)
#pragma unroll
            for (int m = 0; m < 4; ++m) { f32x4 v[2];
#pragma unroll
                for (int n = 0; n < 2; ++n) { const f32x4 gg = acc[ai][0][m][n], uu = acc[ai][1][m][n];
#pragma unroll
                    for (int j = 0; j < 4; ++j) v[n][j] = gg[j] * fast_sigmoid(gg[j]) * uu[j]; }
                *(u32x4*)(O + (size_t)(row0 + ai * HALF + m * 16) * ldo + col0) = pack8(v[0], v[1]); }
    }
};
struct EpiGlu { static constexpr bool PERM = true; bf16_t* O; int ldo;
    __device__ __forceinline__ void operator()(const Acc& acc, const Unit& u, int wr, int wc, int fr, int fq) const {
        const int row0 = u.pm * BM + wr * 64 + fr, col0 = u.pn * 128 + wc * 32 + 8 * fq;
#pragma unroll
        for (int ai = 0; ai < 2; ++ai)
#pragma unroll
            for (int m = 0; m < 4; ++m) { f32x4 v[2];
#pragma unroll
                for (int n = 0; n < 2; ++n) { const f32x4 aa = acc[ai][0][m][n], bb = acc[ai][1][m][n];
#pragma unroll
                    for (int j = 0; j < 4; ++j) v[n][j] = aa[j] * fast_sigmoid(bb[j]); }
                *(u32x4*)(O + (size_t)(row0 + ai * HALF + m * 16) * ldo + col0) = pack8(v[0], v[1]); }
    }
};
struct EpiResid { static constexpr bool PERM = false; const float* baseL; const float* baseC; float* outL; float* outC; const float* gate; float coef;
    __device__ __forceinline__ void operator()(const Acc& acc, const Unit& u, int wr, int wc, int fr, int fq) const {
        const int src = u.pm < 32 ? 0 : (u.pm < 64 ? 1 : 2);
        const float* gt = gate + (size_t)src * NMOD;
        const float* base = u.pm < 64 ? baseL + (size_t)u.pm * BM * D : baseC + (size_t)(u.pm - 64) * BM * D;
        float* out = u.pm < 64 ? outL + (size_t)u.pm * BM * D : outC + (size_t)(u.pm - 64) * BM * D;
        const int col0 = u.pn * BM + wc * 32 + 4 * fq;
        f32x4 gv[2][2];
#pragma unroll
        for (int bj = 0; bj < 2; ++bj)
#pragma unroll
            for (int n = 0; n < 2; ++n) gv[bj][n] = *(const f32x4*)(gt + col0 + bj * HALF + n * 16) * coef;
#pragma unroll
        for (int ai = 0; ai < 2; ++ai)
#pragma unroll
            for (int m = 0; m < 4; ++m) { const size_t off = (size_t)(wr * 64 + fr + ai * HALF + m * 16) * D + col0;
#pragma unroll
                for (int bj = 0; bj < 2; ++bj)
#pragma unroll
                    for (int n = 0; n < 2; ++n) { const f32x4 b = *(const f32x4*)(base + off + bj * HALF + n * 16); *(f32x4*)(out + off + bj * HALF + n * 16) = b + gv[bj][n] * acc[ai][bj][m][n]; } }
    }
};
struct EpiIn { static constexpr bool PERM = true;
    int mode;
    bf16_t* UA; bf16_t* QB; int qp; bf16_t* KB; bf16_t* VB; int kp; const float* qkg; const float* rope;
    __device__ __forceinline__ void operator()(const Acc& acc, const Unit& u, int wr, int wc, int fr, int fq) const {
        int role, head;
        if (mode == 0) { if (u.pn < 2) { role = 0; head = 0; } else if (u.pn < 4) { role = 1; head = 4 * (u.pn - 2) + wc; } else { role = (wc < 2) ? 2 : 3; head = wc & 1; } }
        else { if (u.pn < 4) { role = 1; head = 4 * u.pn + wc; } else if (u.pn == 4) { role = 2; head = wc; } else { role = 3; head = wc; } }
        const bool isctx = u.pm >= 64;
        if (role == 1 && isctx && mode == 1) return;
        const int rbase = u.pm * BM + wr * 64 + fr;
        if (role == 0) {
#pragma unroll
            for (int ai = 0; ai < 2; ++ai)
#pragma unroll
                for (int m = 0; m < 4; ++m) { const int R = rbase + ai * HALF + m * 16; const int ch = isctx ? NCH_LAT + ((R - NLAT) >> 5) : (R >> 5); const int s = R & 31;
#pragma unroll
                    for (int bj = 0; bj < 2; ++bj) { const int cu = u.pn * BM + bj * HALF + wc * 32 + 8 * fq; const int g = cu >> 4, j0 = cu & 15;
                        *(u32x4*)(UA + ((size_t)(g * NCH_PAD + ch) * S5K + s * 16 + j0)) = pack8(acc[ai][bj][m][0], acc[ai][bj][m][1]); } }
            return;
        }
        f32x4 glo[2], ghi[2];
        if (role != 3) { const float* gp = qkg + (role == 1 ? 0 : HD) + 8 * fq; glo[0] = *(const f32x4*)gp; glo[1] = *(const f32x4*)(gp + 4); ghi[0] = *(const f32x4*)(gp + 32); ghi[1] = *(const f32x4*)(gp + 36); }
        const float qs = (role == 1) ? C2 : 1.f;
#pragma unroll
        for (int ai = 0; ai < 2; ++ai)
#pragma unroll
            for (int m = 0; m < 4; ++m) { const int R = rbase + ai * HALF + m * 16;
                int b, t; if (isctx) { b = (R - NLAT) >> 8; t = (R - NLAT) & 255; } else { b = R >> 13; t = R & 8191; }
                f32x4 lo[2] = {acc[ai][0][m][0], acc[ai][0][m][1]}, hi[2] = {acc[ai][1][m][0], acc[ai][1][m][1]};
                if (role != 3) {
                    float ss = 0.f;
#pragma unroll
                    for (int n = 0; n < 2; ++n)
#pragma unroll
                        for (int j = 0; j < 4; ++j) ss += lo[n][j] * lo[n][j] + hi[n][j] * hi[n][j];
                    ss += __shfl_xor(ss, 16); ss += __shfl_xor(ss, 32);
                    const float rs = rsqrtf(ss * (1.f / HD) + EPS) ;
#pragma unroll
                    for (int n = 0; n < 2; ++n) { lo[n] = lo[n] * rs * glo[n]; hi[n] = hi[n] * rs * ghi[n]; }
                    if (!isctx) {
                        const int pos = (fq < 2) ? (t >> 6) : (t & 63); const float* rp = rope + pos * 32 + 8 * (fq & 1);
#pragma unroll
                        for (int n = 0; n < 2; ++n) { const f32x4 cs = *(const f32x4*)(rp + 4 * n), sn = *(const f32x4*)(rp + 16 + 4 * n);
                            const f32x4 x1 = lo[n], x2 = hi[n]; lo[n] = x1 * cs - x2 * sn; hi[n] = x1 * sn + x2 * cs; }
                    }
#pragma unroll
                    for (int n = 0; n < 2; ++n) { lo[n] = lo[n] * qs; hi[n] = hi[n] * qs; }
                }
                bf16_t* dst;
                if (role == 1) dst = QB + (size_t)R * qp + head * HD + 8 * fq;
                else { const size_t kr = (size_t)b * KVROWS + (isctx ? t : CTX + t); dst = (role == 2 ? KB : VB) + kr * kp + head * HD + 8 * fq; }
                *(u32x4*)dst = pack8(lo[0], lo[1]); *(u32x4*)(dst + 32) = pack8(hi[0], hi[1]);
            }
    }
};
struct EpiS5State { static constexpr bool PERM = false; float* SS;
    __device__ __forceinline__ void operator()(const Acc& acc, const Unit& u, int wr, int wc, int fr, int fq) const {
        const int mt = u.pm % 3; const int col0 = wc * 32 + 4 * fq;
#pragma unroll
        for (int ai = 0; ai < 2; ++ai)
#pragma unroll
            for (int m = 0; m < 4; ++m) { const int rl = wr * 64 + fr + ai * HALF + m * 16; if (mt * BM + rl >= NCH) continue;
                float* rowp = SS + (size_t)(u.pm * BM + rl) * 256 + col0;
#pragma unroll
                for (int bj = 0; bj < 2; ++bj)
#pragma unroll
                    for (int n = 0; n < 2; ++n) *(f32x4*)(rowp + bj * HALF + n * 16) = acc[ai][bj][m][n]; }
    }
};
struct EpiS5Out { static constexpr bool PERM = true; bf16_t* G5;
    __device__ __forceinline__ void operator()(const Acc& acc, const Unit& u, int wr, int wc, int fr, int fq) const {
        const int g = u.pm / 3, mt = u.pm % 3, ntile = u.pn & 1;
#pragma unroll
        for (int ai = 0; ai < 2; ++ai)
#pragma unroll
            for (int m = 0; m < 4; ++m) { const int ch = mt * BM + wr * 64 + fr + ai * HALF + m * 16; if (ch >= NCH) continue;
                const int rowbase = ch < NCH_LAT ? ch * S5T : NLAT + (ch - NCH_LAT) * S5T;
#pragma unroll
                for (int bj = 0; bj < 2; ++bj) { const int nn = ntile * BM + bj * HALF + wc * 32 + 8 * fq; const int t = nn >> 4, i0 = nn & 15;
                    f32x4 v[2];
#pragma unroll
                    for (int n = 0; n < 2; ++n)
#pragma unroll
                        for (int j = 0; j < 4; ++j) { const float y = acc[ai][bj][m][n][j]; v[n][j] = y * fast_sigmoid(1.5957691216057308f * (y + 0.044715f * y * y * y)); }
                    *(u32x4*)(G5 + (size_t)(rowbase + t) * 512 + g * 16 + i0) = pack8(v[0], v[1]); } }
    }
};
}
namespace attn_body {
using bf16=__hip_bfloat16;
using bf16x8=__attribute__((ext_vector_type(8)))short;
using s16x4=__attribute__((ext_vector_type(4)))short;
using f32x16=__attribute__((ext_vector_type(16)))float;
using u32x4=__attribute__((ext_vector_type(4)))unsigned;
constexpr int D=64;
constexpr int NW=8,QBLK=32,QB=QBLK*NW,KVBLK=64;
__device__ __forceinline__ int crow(int r,int hi){return (r&3)+8*(r>>2)+4*hi;}
#define SBAR() __builtin_amdgcn_sched_barrier(0)
__device__ __forceinline__ void wmask(f32x16&p0,f32x16&p1,int kb0,int qrel,int hi){
  const float NEG=-INFINITY; const int kb=kb0+4*hi-qrel;
  #pragma unroll
  for(int r=0;r<16;++r){const int d=kb+(r&3)+8*(r>>2); if(d>128||d<-128)p0[r]=NEG; if(d+32>128||d+32<-128)p1[r]=NEG;}
}
constexpr int NSLOT=3, SLOTB=8192;
constexpr int LDS_K=0, LDS_V=NSLOT*SLOTB, LDS_WS=2*NSLOT*SLOTB, LDS_OST=LDS_WS+NW*64*4, LDS_BYTES=LDS_OST+NW*4096;
__device__ __forceinline__ void glds16(const void*gsrc,unsigned lds_dst){unsigned keep;
  asm volatile("s_mov_b32 %0, m0\n\ts_mov_b32 m0, %2\n\ts_nop 0\n\tglobal_load_lds_dwordx4 %1, off\n\ts_mov_b32 m0, %0":"=&s"(keep):"v"(gsrc),"s"(lds_dst):"memory");}
__device__ __forceinline__ float max3f(float a,float b,float c){float r;asm("v_max3_f32 %0, %1, %2, %3":"=v"(r):"v"(a),"v"(b),"v"(c));return r;}
__device__ __forceinline__ float max2f(float a,float b){float r;asm("v_max_f32_e32 %0, %1, %2":"=v"(r):"v"(a),"v"(b));return r;}
__device__ __forceinline__ float fadd_s(float a,float b){float r;asm("v_add_f32_e32 %0, %1, %2":"=v"(r):"v"(a),"v"(b));return r;}
__device__ __forceinline__ float fsub_s(float a,float b){float r;asm("v_sub_f32_e32 %0, %1, %2":"=v"(r):"v"(a),"v"(b));return r;}
typedef float f32x2_t __attribute__((ext_vector_type(2))); typedef __bf16 bf16x2_t __attribute__((ext_vector_type(2)));
__device__ __forceinline__ unsigned cvtpk_s(float lo,float hi){f32x2_t v={lo,hi};bf16x2_t b=__builtin_convertvector(v,bf16x2_t);return __builtin_bit_cast(unsigned,b);}
#define WAIT_BAR(N) asm volatile("s_waitcnt vmcnt(" #N ") lgkmcnt(0)\n\ts_barrier":::"memory")

__device__ __forceinline__ void qkt(f32x16&p0,f32x16&p1,const char*Kslot,const bf16x8*qr,const f32x16&negm,int r32,int hi){
  const char*kb=Kslot+hi*1024+r32*16;
  #pragma unroll
  for(int d0=0;d0<4;++d0){
    const bf16x8 b0=*reinterpret_cast<const bf16x8*>(kb+d0*2048);
    const bf16x8 b1=*reinterpret_cast<const bf16x8*>(kb+d0*2048+512);
    if(d0==0){p0=__builtin_amdgcn_mfma_f32_32x32x16_bf16(b0,qr[0],negm,0,0,0);p1=__builtin_amdgcn_mfma_f32_32x32x16_bf16(b1,qr[0],negm,0,0,0);}
    else{p0=__builtin_amdgcn_mfma_f32_32x32x16_bf16(b0,qr[d0],p0,0,0,0);p1=__builtin_amdgcn_mfma_f32_32x32x16_bf16(b1,qr[d0],p1,0,0,0);}}
}
typedef __attribute__((address_space(3))) const char* lds_cptr;
typedef short v4i16_t __attribute__((ext_vector_type(4)));
__device__ __forceinline__ void kload8(bf16x8*kf,lds_cptr kp){
  kf[0]=*(const __attribute__((address_space(3))) bf16x8*)(kp);      kf[1]=*(const __attribute__((address_space(3))) bf16x8*)(kp+512);
  kf[2]=*(const __attribute__((address_space(3))) bf16x8*)(kp+2048); kf[3]=*(const __attribute__((address_space(3))) bf16x8*)(kp+2560);
  kf[4]=*(const __attribute__((address_space(3))) bf16x8*)(kp+4096); kf[5]=*(const __attribute__((address_space(3))) bf16x8*)(kp+4608);
  kf[6]=*(const __attribute__((address_space(3))) bf16x8*)(kp+6144); kf[7]=*(const __attribute__((address_space(3))) bf16x8*)(kp+6656);
}
__device__ __forceinline__ void kload2(bf16x8*kf,lds_cptr kp,int j){ kf[2*j]=*(const __attribute__((address_space(3))) bf16x8*)(kp+j*2048); kf[2*j+1]=*(const __attribute__((address_space(3))) bf16x8*)(kp+j*2048+512); }
__device__ __forceinline__ s16x4 vtr(lds_cptr p){ return __builtin_bit_cast(s16x4,__builtin_amdgcn_ds_read_tr16_b64_v4i16((__attribute__((address_space(3))) v4i16_t*)p)); }
__device__ __forceinline__ float rowmax(const f32x16&p0,const f32x16&p1){
  float a=max3f(p0[0],p0[1],p1[0]),b=max3f(p0[2],p0[3],p1[1]);a=max3f(a,p1[2],p1[3]);
  #pragma unroll
  for(int r=4;r<16;r+=4){a=max3f(a,p0[r],p0[r+1]);b=max3f(b,p0[r+2],p0[r+3]);a=max3f(a,p1[r],p1[r+1]);b=max3f(b,p1[r+2],p1[r+3]);}
  const float m=max2f(a,b);
  auto rr=__builtin_amdgcn_permlane32_swap(__float_as_uint(m),__float_as_uint(m),false,false);
  return max2f(__uint_as_float(rr[0]),__uint_as_float(rr[1]));
}
__device__ __forceinline__ void pv(f32x16*o,int vb,bf16x8 pa0,bf16x8 pa1,bf16x8 pa2,bf16x8 pa3){
  #pragma unroll
  for(int d0=0;d0<2;++d0){s16x4 lo[4],hi[4];
    #pragma unroll
    for(int ks=0;ks<4;++ks){
      asm volatile("ds_read_b64_tr_b16 %0,%1 offset:%c2":"=&v"(lo[ks]):"v"(vb),"i"(d0*4096+ks*1024):"memory");
      asm volatile("ds_read_b64_tr_b16 %0,%1 offset:%c2":"=&v"(hi[ks]):"v"(vb),"i"(d0*4096+ks*1024+512):"memory");}
    asm volatile("s_waitcnt lgkmcnt(0)":::"memory");SBAR();
    #define PK(k) (bf16x8){lo[k][0],lo[k][1],lo[k][2],lo[k][3],hi[k][0],hi[k][1],hi[k][2],hi[k][3]}
    o[d0]=__builtin_amdgcn_mfma_f32_32x32x16_bf16(pa0,PK(0),o[d0],0,0,0);
    o[d0]=__builtin_amdgcn_mfma_f32_32x32x16_bf16(pa1,PK(1),o[d0],0,0,0);
    o[d0]=__builtin_amdgcn_mfma_f32_32x32x16_bf16(pa2,PK(2),o[d0],0,0,0);
    o[d0]=__builtin_amdgcn_mfma_f32_32x32x16_bf16(pa3,PK(3),o[d0],0,0,0);
    #undef PK
  }
}

#ifndef ATTN_STORE16
#define ATTN_STORE16(p,v) (*(u32x4*)(p)=(v))
#endif
template<int MODE,int THRL> __device__ __forceinline__ void attn_unit(const bf16*Qw0,int qp,const bf16*__restrict__ Kh,const bf16*__restrict__ Vh,int kp,bf16*Ow0,int op,int NT,int loc_row0,int krel0,float sink_l2,char*shm,const int tid){
  const int lane=tid&63,r32=lane&31,hi=lane>>5; const int wid=__builtin_amdgcn_readfirstlane(tid>>6);
  const bf16*Qw=Qw0+(long)wid*QBLK*qp;
  const unsigned lds0=(unsigned)(uintptr_t)shm;
  float*wsf=(float*)(shm+LDS_WS)+wid*64;
  const bf16*ksrc=Kh+(long)lane*kp+wid*8;
  const bf16*vsrc=Vh+(long)(16*(wid&3)+(lane>>2))*kp+(wid>>2)*32+(lane&3)*8;
  #define TROW(t) ((MODE==1&&(t)>=4)?(loc_row0+64*((t)-4)):(64*(t)))
  const unsigned kdst=lds0+LDS_K+wid*1024, vdst=lds0+LDS_V+wid*1024;
  #define DMA_K(t,slot) glds16(ksrc+(long)TROW(t)*kp,(unsigned)__builtin_amdgcn_readfirstlane(kdst+(slot)))
  #define DMA_V(t,slot) glds16(vsrc+(long)TROW(t)*kp,(unsigned)__builtin_amdgcn_readfirstlane(vdst+(slot)))
  const int vb0=(int)(lds0+LDS_V)+((lane>>4)&1)*32+(lane&3)*8+(4*hi+((lane&15)>>2))*64;
  const char*Kbase=shm+LDS_K; bf16x8 kf[8];
  const lds_cptr shm3=(lds_cptr)shm; const lds_cptr kp0=shm3+LDS_K+hi*1024+r32*16; const lds_cptr vp0=shm3+LDS_V+((lane>>4)&1)*32+(lane&3)*8+(4*hi+((lane&15)>>2))*64;
  DMA_K(0,0);DMA_V(0,0);DMA_K(1,SLOTB);
  bf16x8 qr[4];
  #pragma unroll
  for(int d0=0;d0<4;++d0)qr[d0]=*reinterpret_cast<const bf16x8*>(&Qw[(long)r32*qp+d0*16+hi*8]);
  float zf=0.f;asm volatile("":"+v"(zf));
  float mhat=0.f,l_reg=0.f;f32x16 o[2];f32x16 negm;
  #pragma unroll
  for(int r=0;r<16;++r){o[0][r]=zf;o[1][r]=zf;negm[r]=zf;}
  asm volatile("":"+v"(negm));
  const int qrel=wid*QBLK+r32;
  #define CMASK(P0,P1,t) do{ if(MODE==1&&(t)>=4) wmask(P0,P1,krel0+64*((t)-4),qrel,hi); }while(0)
  bool resc=false;
  #define START(P0,P1) do{ const float rm=rowmax(P0,P1); resc=false; \
    { const float dl=rm; mhat=fadd_s(mhat,dl); \
      _Pragma("unroll") for(int r=0;r<16;++r){P0[r]=fsub_s(P0[r],dl);P1[r]=fsub_s(P1[r],dl);} \
      _Pragma("unroll") for(int r=0;r<16;++r)negm[r]=-mhat; asm volatile("":"+v"(negm)); } \
    _Pragma("unroll") for(int r=0;r<16;++r)P0[r]=__builtin_amdgcn_exp2f(P0[r]); }while(0)
  #define RESC() do{ if(resc){ asm volatile("s_waitcnt lgkmcnt(0)":::"memory"); \
      _Pragma("unroll") for(int d_=0;d_<2;++d_) _Pragma("unroll") for(int r=0;r<16;++r)o[d_][r]*=wsf[crow(r,hi)]; } }while(0)
  f32x16 pA0,pA1,pB0,pB1;
  int sl_prev=0,sl_cur=0,sl_next=SLOTB;
  #define ROT() do{sl_prev=sl_cur;sl_cur=sl_next;sl_next=(sl_next==(NSLOT-1)*SLOTB)?0:sl_next+SLOTB;}while(0)
  DMA_K(2,2*SLOTB);
  WAIT_BAR(3);
  qkt(pA0,pA1,Kbase,qr,negm,r32,hi);asm volatile("s_nop 15\n\ts_nop 7":"+v"(pA0),"+v"(pA1));CMASK(pA0,pA1,0);
  START(pA0,pA1);
  _Pragma("unroll") for(int r=0;r<16;++r)pA1[r]=__builtin_amdgcn_exp2f(pA1[r]);
  WAIT_BAR(0);
  DMA_K(3,0);DMA_V(1,SLOTB);
  ROT();
  kload8(kf,kp0+sl_cur);
  WAIT_BAR(2);
  s16x4 vlo[8],vhi[8]; u32x4 pw0,pw1,pw2,pw3;
  #define PKW(P,B) cvtpk_s(P[B],P[B+1])
  #define PAF(k) __builtin_bit_cast(bf16x8,pw##k)
  #define VFR(i) (bf16x8){vlo[i][0],vlo[i][1],vlo[i][2],vlo[i][3],vhi[i][0],vhi[i][1],vhi[i][2],vhi[i][3]}
  #define PIN(x) asm volatile("":"+v"(x))
  #define MX3(a,b,c) __builtin_fmaxf(__builtin_fmaxf((a),(b)),(c))
  #define GAPA(MF,A0,A1,A2,A3,W0,W1,PW) do{ MF; sacc+=A0; sacc+=A1; sacc+=A2; sacc+=A3; PIN(sacc); W0; W1; PIN(PW); SBAR(); }while(0)
  #define EX(v) __builtin_amdgcn_exp2f(v)
  #define GAPB(MF,X,B) do{ MF; X[B]=EX(X[B]); X[B+1]=EX(X[B+1]); X[B+2]=EX(X[B+2]); X[B+3]=EX(X[B+3]); PIN(X); SBAR(); }while(0)
  #define VRD(i) do{ vlo[i]=vtr(vp_+(((i)>>2)*4096+((i)&3)*1024)); vhi[i]=vtr(vp_+(((i)>>2)*4096+((i)&3)*1024+512)); }while(0)
  #define KRD(G,j) do{ if(G){ kload2(kf,kp0+sl_next,j); SBAR(); } }while(0)
  #define STEP(C0,C1,P0,P1,t,GK,GV,GL) do{ SBAR(); \
    const lds_cptr vp_=vp0+sl_prev; \
    VRD(0); SBAR(); float sacc=(P0[0]+P0[1]); \
    GAPA(C0=__builtin_amdgcn_mfma_f32_32x32x16_bf16(kf[0],qr[0],negm,0,0,0), P0[2],P0[3],P0[4],P0[5],     pw0[0]=PKW(P0,0), pw0[1]=PKW(P0,2), pw0); \
    VRD(4); SBAR(); GAPA(C1=__builtin_amdgcn_mfma_f32_32x32x16_bf16(kf[1],qr[0],negm,0,0,0), P0[6],P0[7],P0[8],P0[9],     pw0[2]=PKW(P0,4), pw0[3]=PKW(P0,6), pw0); \
    VRD(1); SBAR(); GAPA(C0=__builtin_amdgcn_mfma_f32_32x32x16_bf16(kf[2],qr[1],C0,0,0,0),   P0[10],P0[11],P0[12],P0[13], pw1[0]=PKW(P0,8), pw1[1]=PKW(P0,10), pw1); \
    VRD(5); SBAR(); GAPA(C1=__builtin_amdgcn_mfma_f32_32x32x16_bf16(kf[3],qr[1],C1,0,0,0),   P0[14],P0[15],P1[0],P1[1],   pw1[2]=PKW(P0,12),pw1[3]=PKW(P0,14), pw1); \
    VRD(2); SBAR(); GAPA(C0=__builtin_amdgcn_mfma_f32_32x32x16_bf16(kf[4],qr[2],C0,0,0,0),   P1[2],P1[3],P1[4],P1[5],     pw2[0]=PKW(P1,0), pw2[1]=PKW(P1,2), pw2); \
    VRD(6); SBAR(); GAPA(C1=__builtin_amdgcn_mfma_f32_32x32x16_bf16(kf[5],qr[2],C1,0,0,0),   P1[6],P1[7],P1[8],P1[9],     pw2[2]=PKW(P1,4), pw2[3]=PKW(P1,6), pw2); \
    VRD(3); SBAR(); GAPA(C0=__builtin_amdgcn_mfma_f32_32x32x16_bf16(kf[6],qr[3],C0,0,0,0),   P1[10],P1[11],P1[12],P1[13], pw3[0]=PKW(P1,8), pw3[1]=PKW(P1,10), pw3); \
    VRD(7); SBAR(); GAPA(C1=__builtin_amdgcn_mfma_f32_32x32x16_bf16(kf[7],qr[3],C1,0,0,0),   P1[14],P1[15],0.f,0.f,       pw3[2]=PKW(P1,12),pw3[3]=PKW(P1,14), pw3); \
    l_reg+=sacc; \
    if(GK){DMA_K((t)+3,sl_cur);} if(GV){DMA_V((t)+1,sl_next);} \
    CMASK(C0,C1,t); \
    { float a=MX3(C0[0],C0[1],C1[0]),b=MX3(C0[2],C0[3],C1[1]); a=MX3(a,C1[2],C1[3]); \
      _Pragma("unroll") for(int r=4;r<16;r+=4){a=MX3(a,C0[r],C0[r+1]);b=MX3(b,C0[r+2],C0[r+3]);a=MX3(a,C1[r],C1[r+1]);b=MX3(b,C1[r+2],C1[r+3]);} \
      float rm=__builtin_fmaxf(a,b); { auto rr=__builtin_amdgcn_permlane32_swap(__float_as_uint(rm),__float_as_uint(rm),false,false); rm=__builtin_fmaxf(__uint_as_float(rr[0]),__uint_as_float(rr[1])); } \
      resc=false; \
      if(__builtin_expect(__any(rm>(float)THRL),0)){ const float dl=__builtin_fmaxf(rm,0.f); mhat+=dl; \
        _Pragma("unroll") for(int r=0;r<16;++r){C0[r]-=dl;C1[r]-=dl;} \
        _Pragma("unroll") for(int r=0;r<16;++r)negm[r]=-mhat; asm volatile("":"+v"(negm)); \
        const float f=__builtin_amdgcn_exp2f(-dl); l_reg*=f; if(hi==0)wsf[r32]=f; resc=true; } } \
    SBAR(); \
    GAPB(o[0]=__builtin_amdgcn_mfma_f32_32x32x16_bf16(PAF(0),VFR(0),o[0],0,0,0), C0,0); \
    GAPB(o[1]=__builtin_amdgcn_mfma_f32_32x32x16_bf16(PAF(0),VFR(4),o[1],0,0,0), C0,4); \
    KRD(GL,0); GAPB(o[0]=__builtin_amdgcn_mfma_f32_32x32x16_bf16(PAF(1),VFR(1),o[0],0,0,0), C0,8); \
    KRD(GL,1); GAPB(o[1]=__builtin_amdgcn_mfma_f32_32x32x16_bf16(PAF(1),VFR(5),o[1],0,0,0), C0,12); \
    KRD(GL,2); GAPB(o[0]=__builtin_amdgcn_mfma_f32_32x32x16_bf16(PAF(2),VFR(2),o[0],0,0,0), C1,0); \
    KRD(GL,3); GAPB(o[1]=__builtin_amdgcn_mfma_f32_32x32x16_bf16(PAF(2),VFR(6),o[1],0,0,0), C1,4); \
    GAPB(o[0]=__builtin_amdgcn_mfma_f32_32x32x16_bf16(PAF(3),VFR(3),o[0],0,0,0), C1,8); \
    GAPB(o[1]=__builtin_amdgcn_mfma_f32_32x32x16_bf16(PAF(3),VFR(7),o[1],0,0,0), C1,12); \
    }while(0)
  int t=1;
  for(;t+5<NT;t+=2){
    STEP(pB0,pB1,pA0,pA1,t,true,true,true);     WAIT_BAR(2); RESC(); ROT();
    STEP(pA0,pA1,pB0,pB1,t+1,true,true,true);   WAIT_BAR(2); RESC(); ROT();
  }
  #define ENDW(tt) do{ if((tt)+3<NT){WAIT_BAR(2);} else if((tt)+2<NT){WAIT_BAR(1);} else {WAIT_BAR(0);} }while(0)
  for(;t+1<NT;t+=2){
    STEP(pB0,pB1,pA0,pA1,t,(t+3<NT),(t+1<NT),(t+1<NT));       ENDW(t);   RESC(); ROT();
    STEP(pA0,pA1,pB0,pB1,t+1,(t+4<NT),(t+2<NT),(t+2<NT));     ENDW(t+1); RESC(); ROT();
  }
  STEP(pB0,pB1,pA0,pA1,NT-1,false,false,false); RESC();
  { float sacc=pB0[0]+pB0[1]; _Pragma("unroll") for(int r=2;r<16;++r)sacc+=pB0[r]; _Pragma("unroll") for(int r=0;r<16;++r)sacc+=pB1[r]; l_reg+=sacc;
    pw0=(u32x4){PKW(pB0,0),PKW(pB0,2),PKW(pB0,4),PKW(pB0,6)};pw1=(u32x4){PKW(pB0,8),PKW(pB0,10),PKW(pB0,12),PKW(pB0,14)};pw2=(u32x4){PKW(pB1,0),PKW(pB1,2),PKW(pB1,4),PKW(pB1,6)};pw3=(u32x4){PKW(pB1,8),PKW(pB1,10),PKW(pB1,12),PKW(pB1,14)};
    SBAR(); pv(o,vb0+sl_cur,PAF(0),PAF(1),PAF(2),PAF(3)); }
  #undef PKW
  #undef PAF
  #undef VFR
  #undef PIN
  #undef MX3
  #undef GAPA
  #undef GAPB
  #undef EX
  #undef VRD
  #undef KRD
  #undef STEP
  #undef ENDW
  {auto rr=__builtin_amdgcn_permlane32_swap(__float_as_uint(l_reg),__float_as_uint(l_reg),false,false);l_reg=__uint_as_float(rr[0])+__uint_as_float(rr[1]);}
  l_reg+=__builtin_amdgcn_exp2f(sink_l2-mhat);
  if(hi==0)wsf[32+r32]=l_reg;asm volatile("s_waitcnt lgkmcnt(0)":::"memory");
  float rli[16];
  #pragma unroll
  for(int r=0;r<16;++r)rli[r]=__builtin_amdgcn_rcpf(wsf[32+crow(r,hi)]);
  bf16*Ow=Ow0+(long)wid*QBLK*op;
  { bf16*stg=(bf16*)(shm+LDS_OST)+wid*2048;
    #pragma unroll
    for(int r=0;r<16;++r){const int orow=crow(r,hi);
      #pragma unroll
      for(int d0=0;d0<2;++d0)stg[orow*64+d0*32+r32]=__float2bfloat16(o[d0][r]*rli[r]);}
    asm volatile("s_waitcnt lgkmcnt(0)":::"memory");
    #pragma unroll
    for(int i=0;i<4;++i){const int row=i*8+(lane>>3),ch=lane&7; const u32x4 v=*(const u32x4*)(stg+row*64+ch*8); ATTN_STORE16(Ow+(long)row*op+ch*8,v);} }
  asm volatile("s_waitcnt lgkmcnt(0)\n\ts_barrier":::"memory");
  #undef DMA_K
  #undef TROW
  #undef DMA_V
  #undef CMASK
  #undef START
  #undef RESC
  #undef ROT
}
constexpr int ATTN_LDS_BYTES=LDS_BYTES;
#undef SBAR
#undef WAIT_BAR
}
namespace cg = cooperative_groups;
using namespace cfg;
typedef unsigned short bf16;
#define LAS __attribute__((address_space(3)))
typedef float f32x4 __attribute__((ext_vector_type(4)));
typedef unsigned v4u __attribute__((ext_vector_type(4)));
typedef unsigned v2u __attribute__((ext_vector_type(2)));
constexpr int NWAVES = 8;
constexpr int RING_BYTES = 131072, LDS_BYTES = 147456;

__host__ __device__ constexpr size_t al256(size_t x) { return (x + 255) & ~(size_t)255; }
constexpr size_t WS_CTL = 0, CTL_BYTES = 65536;
constexpr size_t WS_MOD = WS_CTL + CTL_BYTES;
constexpr size_t WS_ROPE = WS_MOD + al256((size_t)2 * 3 * NMOD * 4);
constexpr size_t WS_XC = WS_ROPE + al256(128 * 32 * 4);
constexpr size_t WS_W1T = WS_XC + al256((size_t)NCTX * D * 4);
constexpr size_t W1T_ONE = (size_t)2 * DFF * D * 2;
constexpr size_t WS_W2T = WS_W1T + 4 * W1T_ONE;
constexpr size_t W2T_ONE = (size_t)D * DFF * 2;
constexpr size_t WS_WINAB = WS_W2T + 4 * W2T_ONE;
constexpr size_t WS_WINW = WS_WINAB + (size_t)1280 * D * 2;
constexpr size_t WS_WOUT = WS_WINW + (size_t)1536 * D * 2;
constexpr size_t WS_GLUT = WS_WOUT + (size_t)2 * D * D * 2;
constexpr size_t WS_FS = WS_GLUT + (size_t)1024 * 512 * 2;
constexpr size_t WS_OUTM = WS_FS + (size_t)32 * 256 * 512 * 2;
constexpr size_t WS_HN = WS_OUTM + (size_t)32 * 512 * S5K * 2;
constexpr size_t WS_REG = WS_HN + (size_t)MALL * D * 2;
constexpr size_t R_ACT = 0;
constexpr size_t R_CAT = 0;
constexpr size_t R_QB = R_CAT + (size_t)MALL * D * 2;
constexpr size_t KV_ROWS_PAD = (size_t)BATCH * KVROWS + 64;
constexpr size_t R0_KB = R_QB + (size_t)MALL * 512 * 2, R0_VB = R0_KB + KV_ROWS_PAD * 128 * 2;
constexpr size_t R0_UA = R0_VB + KV_ROWS_PAD * 128 * 2;
constexpr size_t R0_SS = R0_UA + (size_t)32 * NCH_PAD * S5K * 2;
constexpr size_t R0_G5 = R0_SS + (size_t)32 * NCH_PAD * 256 * 4;
constexpr size_t R0_END = R0_G5 + (size_t)MALL * 512 * 2;
constexpr size_t R1_KB = R_QB + (size_t)NLAT * 1024 * 2, R1_VB = R1_KB + KV_ROWS_PAD * 256 * 2, R1_END = R1_VB + KV_ROWS_PAD * 256 * 2;
constexpr size_t R_ACT_END = (size_t)MALL * DFF * 2;
constexpr size_t REG_BYTES = R0_END > R_ACT_END ? (R0_END > R1_END ? R0_END : R1_END) : (R_ACT_END > R1_END ? R_ACT_END : R1_END);
constexpr size_t WS_END = WS_REG + REG_BYTES;
static_assert(WS_END < (size_t)304 * 1000 * 1000, "workspace map must fit under the sum of the inputs (~306 MB)");

enum Op { OP_PROLOGUE = 0, OP_NORM, OP_FFNA, OP_FFNB, OP_INAB, OP_S5STATE, OP_S5SCAN, OP_S5OUT, OP_GLU, OP_ATTN0, OP_INWIN, OP_ATTN1, OP_WOUT };
struct Args { const float* in[24]; float* out; unsigned char* ws; int k_lo, k_hi; };

struct Frame {
    LAS unsigned char* lds; int tid, lane, wave, vcu, G;
    float* out; unsigned char* ws;
};
#define FIN(i) (A.in[i])
__device__ __forceinline__ float wave_sum(float v) {
#pragma unroll
    for (int o = 1; o < 64; o <<= 1) v += __shfl_xor(v, o);
    return v;
}
__device__ __forceinline__ unsigned f2bf(float f) { unsigned u = __builtin_bit_cast(unsigned, f); return (u + 0x7fffu + ((u >> 16) & 1u)) >> 16; }
__device__ __forceinline__ unsigned pk2(float lo, float hi) { return f2bf(lo) | (f2bf(hi) << 16); }
__device__ __forceinline__ float silu_f(float x) { return x / (1.f + __expf(-x)); }

__device__ __forceinline__ void transpose_item(const float* W, int ldw, int col0, int K, bf16* WT, int n0, int kb, LAS float* scr, int lane) {
    const int k0 = 64 * kb;
#pragma unroll 8
    for (int i = 0; i < 32; ++i) { const int kk = 2 * i + (lane >> 5); scr[kk * 33 + (lane & 31)] = W[(size_t)(k0 + kk) * ldw + col0 + (lane & 31)]; }
    asm volatile("s_waitcnt lgkmcnt(0)" ::: "memory");
    const int c = lane & 7;
#pragma unroll
    for (int j = 0; j < 4; ++j) { const int n = (lane >> 3) + 8 * j; const LAS float* s = scr + (8 * c) * 33 + n;
        v4u o; o.x = pk2(s[0 * 33], s[1 * 33]); o.y = pk2(s[2 * 33], s[3 * 33]); o.z = pk2(s[4 * 33], s[5 * 33]); o.w = pk2(s[6 * 33], s[7 * 33]);
        *(v4u*)(WT + (size_t)(n0 + n) * K + k0 + 8 * c) = o; }
    asm volatile("s_waitcnt lgkmcnt(0)" ::: "memory");
}
__device__ __forceinline__ int headcol(int p) { const int bj = p >> 7, k = (p & 127) >> 5; return k * 64 + 32 * bj; }

__device__ __forceinline__ void prologue_transposes(Frame& F, const Args& A) {
    LAS float* scr = (LAS float*)(F.lds + F.wave * 16384);
    const int gw = F.vcu * NWAVES + F.wave, NGW = F.G * NWAVES;
    constexpr int I_W1 = (D / 64) * (2 * DFF / 32), I_W2 = (DFF / 64) * (D / 32), I_AB = 16 * (1280 / 32), I_WIN = 16 * (1536 / 32), I_WO = 16 * 32, I_GLU = 8 * (1024 / 32);
    constexpr int NIT = 4 * I_W1 + 4 * I_W2 + I_AB + I_WIN + 2 * I_WO + I_GLU;
    for (int it = gw; it < NIT; it += NGW) {
        int r = it;
        if (r < 4 * I_W1) { const int lw = r / I_W1; r %= I_W1; const int nb = r % (2 * DFF / 32), kb = r / (2 * DFF / 32); const int n0 = nb * 32, tile = n0 >> 8, p = n0 & 255;
            const float* W = (p < 128 ? FIN(7) : FIN(8)) + (size_t)lw * D * DFF;
            transpose_item(W, DFF, tile * 128 + (p & 127), D, (bf16*)(F.ws + WS_W1T + lw * W1T_ONE), n0, kb, scr, F.lane); continue; }
        r -= 4 * I_W1;
        if (r < 4 * I_W2) { const int lw = r / I_W2; r %= I_W2; const int nb = r % (D / 32), kb = r / (D / 32);
            transpose_item(FIN(9) + (size_t)lw * DFF * D, D, nb * 32, DFF, (bf16*)(F.ws + WS_W2T + lw * W2T_ONE), nb * 32, kb, scr, F.lane); continue; }
        r -= 4 * I_W2;
        if (r < I_AB) { const int nb = r % 40, kb = r / 40; const int n0 = nb * 32, tile = n0 >> 8; const int col0 = tile < 2 ? n0 : tile * 256 + headcol(n0 & 255);
            transpose_item(FIN(12), 1280, col0, D, (bf16*)(F.ws + WS_WINAB), n0, kb, scr, F.lane); continue; }
        r -= I_AB;
        if (r < I_WIN) { const int nb = r % 48, kb = r / 48; const int n0 = nb * 32, tile = n0 >> 8; const int col0 = tile * 256 + headcol(n0 & 255);
            transpose_item(FIN(22), 1536, col0, D, (bf16*)(F.ws + WS_WINW), n0, kb, scr, F.lane); continue; }
        r -= I_WIN;
        if (r < 2 * I_WO) { const int l = r / I_WO; r %= I_WO; const int nb = r % 32, kb = r / 32;
            transpose_item(FIN(10) + (size_t)l * D * D, D, nb * 32, D, (bf16*)(F.ws + WS_WOUT) + (size_t)l * D * D, nb * 32, kb, scr, F.lane); continue; }
        r -= 2 * I_WO;
        { const int nb = r % 32, kb = r / 32; const int n0 = nb * 32, tile = n0 >> 8, p = n0 & 255;
            transpose_item(FIN(21) + (p < 128 ? 0 : 512 * 512), 512, tile * 128 + (p & 127), 512, (bf16*)(F.ws + WS_GLUT), n0, kb, scr, F.lane); }
    }
}
__device__ __forceinline__ void prologue_mod(Frame& F, const Args& A) {
    LAS float* sl = (LAS float*)F.lds;
    LAS float* red = sl + 3 * 1024;
    for (int i = F.tid; i < 3 * 1024; i += NWAVES * 64) { const int s = i >> 10, k = i & 1023; const float v = s < 2 ? FIN(1)[s * D + k] : FIN(3)[k]; sl[i] = silu_f(v); }
    __syncthreads();
    float* MOD = (float*)(F.ws + WS_MOD);
    for (int it = F.vcu; it < 2 * (NMOD / 64); it += F.G) {
        const int l = it / (NMOD / 64), cb = it % (NMOD / 64); const int col = cb * 64 + F.lane;
        const float* W = FIN(4) + (size_t)l * D * NMOD + col;
        float a0 = 0.f, a1 = 0.f, a2 = 0.f; const int kbeg = F.wave * 128;
#pragma unroll 8
        for (int k = kbeg; k < kbeg + 128; ++k) { const float w = W[(size_t)k * NMOD]; a0 += sl[k] * w; a1 += sl[1024 + k] * w; a2 += sl[2048 + k] * w; }
        red[(F.wave * 3 + 0) * 64 + F.lane] = a0; red[(F.wave * 3 + 1) * 64 + F.lane] = a1; red[(F.wave * 3 + 2) * 64 + F.lane] = a2;
        __syncthreads();
        if (F.tid < 192) { const int s = F.tid >> 6, c = F.tid & 63; float v = 0.f;
#pragma unroll
            for (int w = 0; w < 8; ++w) v += red[(w * 3 + s) * 64 + c];
            MOD[((size_t)l * 3 + s) * NMOD + cb * 64 + c] = v + FIN(5)[l * NMOD + cb * 64 + c]; }
        __syncthreads();
    }
}
__device__ __forceinline__ void prologue_rope(Frame& F, const Args& A) {
    float* R = (float*)(F.ws + WS_ROPE);
    for (int i = F.tid; i < 128 * 16; i += NWAVES * 64) { const int pos = i >> 4, f = i & 15; const float inv = powf(10000.f, -(float)f / 16.f); const float ang = (float)pos * inv;
        R[pos * 32 + f] = cosf(ang); R[pos * 32 + 16 + f] = sinf(ang); }
}
__device__ __forceinline__ void prologue_s5_item(Frame& F, const Args& A, int g, int dir) {
    LAS float* PW = (LAS float*)F.lds;
    LAS float* BB = PW + 64 * 34 * 2;
    LAS float* CC = BB + 64 * 16 * 2;
    LAS float* BO = CC + 16 * 64 * 2;
    LAS float* CO = BO + 64 * 16 * 2;
    LAS float* KT = CO + 16 * 64 * 2;
    LAS float* KD = KT + 32 * 256;
    const float* lam_re = FIN(13); const float* lam_im = FIN(14); const float* b_re = FIN(15); const float* b_im = FIN(16); const float* c_re = FIN(17); const float* c_im = FIN(18); const float* lstep = FIN(19);
    __syncthreads();
    for (int dd = 0; dd < 2; ++dd) {
        const int gi = (dd == 0 ? dir : 1 - dir) * 32 + g; LAS float* Bd = dd == 0 ? BB : BO; LAS float* Cd = dd == 0 ? CC : CO;
        const float dt = expf(lstep[gi]);
        if (dd == 0) for (int i = F.tid; i < 64 * 33; i += NWAVES * 64) { const int p = i / 33, tau = i % 33;
            const float lre = fminf(lam_re[gi * 64 + p], -1e-4f), lim = lam_im[gi * 64 + p]; const float e = expf(lre * dt * (float)tau); float sn, cs; sincosf(lim * dt * (float)tau, &sn, &cs);
            PW[(p * 34 + tau) * 2] = e * cs; PW[(p * 34 + tau) * 2 + 1] = e * sn; }
        for (int i = F.tid; i < 64 * 16; i += NWAVES * 64) { const int p = i >> 4, j = i & 15;
            const float lre = fminf(lam_re[gi * 64 + p], -1e-4f), lim = lam_im[gi * 64 + p]; const float er = expf(lre * dt); float sn, cs; sincosf(lim * dt, &sn, &cs);
            const float nr = er * cs - 1.f, ni = er * sn, den = lre * lre + lim * lim; const float fr = (nr * lre + ni * lim) / den, fi = (ni * lre - nr * lim) / den;
            const float xr = b_re[((size_t)gi * 64 + p) * 16 + j], xi = b_im[((size_t)gi * 64 + p) * 16 + j];
            Bd[(p * 16 + j) * 2] = fr * xr - fi * xi; Bd[(p * 16 + j) * 2 + 1] = fr * xi + fi * xr;
            const int ii = j; Cd[(ii * 64 + p) * 2] = c_re[((size_t)gi * 16 + ii) * 64 + p]; Cd[(ii * 64 + p) * 2 + 1] = c_im[((size_t)gi * 16 + ii) * 64 + p]; }
    }
    __syncthreads();
    for (int e = F.tid; e < 32 * 256; e += NWAVES * 64) { const int tau = e >> 8, i = (e >> 4) & 15, j = e & 15; float acc = 0.f;
        for (int p = 0; p < 64; ++p) { const float cr = CC[(i * 64 + p) * 2], ci = CC[(i * 64 + p) * 2 + 1], wr_ = PW[(p * 34 + tau) * 2], wi = PW[(p * 34 + tau) * 2 + 1], br = BB[(p * 16 + j) * 2], bi = BB[(p * 16 + j) * 2 + 1];
            const float zr = cr * wr_ - ci * wi, zi = cr * wi + ci * wr_; acc += zr * br - zi * bi; }
        KT[e] = acc; }
    if (dir == 0) for (int e = F.tid; e < 256; e += NWAVES * 64) { const int i = e >> 4, j = e & 15; float acc = 0.f;
        for (int p = 0; p < 64; ++p) acc += CO[(i * 64 + p) * 2] * BO[(p * 16 + j) * 2] - CO[(i * 64 + p) * 2 + 1] * BO[(p * 16 + j) * 2 + 1];
        KD[e] = acc + (i == j ? FIN(20)[g * 16 + i] : 0.f); }
    __syncthreads();
    bf16* OUTM = (bf16*)(F.ws + WS_OUTM) + (size_t)g * 512 * S5K; bf16* FS = (bf16*)(F.ws + WS_FS) + (size_t)g * 256 * 512;
    for (int e = F.tid; e < 512 * 32 * 2; e += NWAVES * 64) { const int half = e & 1, s = (e >> 1) & 31, row = e >> 6, t = row >> 4, i = row & 15;
        if (dir == 0 ? (s > t) : (s <= t)) continue;
        const int tau = dir == 0 ? t - s : s - t; float v[8];
#pragma unroll
        for (int q = 0; q < 8; ++q) { v[q] = KT[tau * 256 + i * 16 + half * 8 + q]; if (dir == 0 && s == t) v[q] += KD[i * 16 + half * 8 + q]; }
        v4u o; o.x = pk2(v[0], v[1]); o.y = pk2(v[2], v[3]); o.z = pk2(v[4], v[5]); o.w = pk2(v[6], v[7]);
        *(v4u*)(OUTM + (size_t)row * S5K + s * 16 + half * 8) = o; }
    for (int e = F.tid; e < 512 * 16; e += NWAVES * 64) { const int pq = e & 15, row = e >> 4, t = row >> 4, i = row & 15; const int tau = dir == 0 ? t + 1 : S5T - t; float v[8];
#pragma unroll
        for (int q = 0; q < 4; ++q) { const int p = pq * 4 + q; const float cr = CC[(i * 64 + p) * 2], ci = CC[(i * 64 + p) * 2 + 1], wr_ = PW[(p * 34 + tau) * 2], wi = PW[(p * 34 + tau) * 2 + 1];
            v[2 * q] = cr * wr_ - ci * wi; v[2 * q + 1] = -(cr * wi + ci * wr_); }
        v4u o; o.x = pk2(v[0], v[1]); o.y = pk2(v[2], v[3]); o.z = pk2(v[4], v[5]); o.w = pk2(v[6], v[7]);
        *(v4u*)(OUTM + (size_t)row * S5K + 512 + dir * 128 + pq * 8) = o; }
    for (int e = F.tid; e < 128 * 32 * 2; e += NWAVES * 64) { const int half = e & 1, s = (e >> 1) & 31, rr = e >> 6, p = rr >> 1, ri = rr & 1; const int tau = dir == 0 ? S5T - 1 - s : s;
        const float wr_ = PW[(p * 34 + tau) * 2], wi = PW[(p * 34 + tau) * 2 + 1]; float v[8];
#pragma unroll
        for (int q = 0; q < 8; ++q) { const float br = BB[(p * 16 + half * 8 + q) * 2], bi = BB[(p * 16 + half * 8 + q) * 2 + 1]; v[q] = ri == 0 ? (wr_ * br - wi * bi) : (wr_ * bi + wi * br); }
        v4u o; o.x = pk2(v[0], v[1]); o.y = pk2(v[2], v[3]); o.z = pk2(v[4], v[5]); o.w = pk2(v[6], v[7]);
        *(v4u*)(FS + (size_t)(dir * 128 + rr) * 512 + s * 16 + half * 8) = o; }
    __syncthreads();
}

__device__ __forceinline__ void norm_phase(Frame& F, const float* xl, const float* xc, const float* gam, const float* MODl, int s, int nrows) {
    const int gw = F.vcu * NWAVES + F.wave, NGW = F.G * NWAVES; bf16* HN = (bf16*)(F.ws + WS_HN);
    for (int r = gw; r < nrows; r += NGW) {
        const float* x = r < NLAT ? xl + (size_t)r * D : xc + (size_t)(r - NLAT) * D;
        const float* m = MODl + (size_t)(r < SEQ ? 0 : (r < NLAT ? 1 : 2)) * NMOD;
        f32x4 v[4]; float ss = 0.f;
#pragma unroll
        for (int j = 0; j < 4; ++j) { v[j] = *(const f32x4*)(x + 4 * F.lane + 256 * j); ss += (v[j].x * v[j].x + v[j].y * v[j].y) + (v[j].z * v[j].z + v[j].w * v[j].w); }
        const float rs = rsqrtf(wave_sum(ss) * (1.f / D) + EPS);
#pragma unroll
        for (int j = 0; j < 4; ++j) { const int c = 4 * F.lane + 256 * j;
            const f32x4 gg = *(const f32x4*)(gam + c), sc = *(const f32x4*)(m + (3 * s + 1) * D + c), sh = *(const f32x4*)(m + (3 * s) * D + c);
            const f32x4 y = v[j] * rs * gg * (sc + 1.f) + sh;
            v2u o; o.x = pk2(y.x, y.y); o.y = pk2(y.z, y.w); *(v2u*)(HN + (size_t)r * D + c) = o; }
    }
}
__device__ __forceinline__ void s5_scan_phase(Frame& F, const Args& A) {
    if (F.wave != 0 || F.vcu >= 128) return;
    const int item = F.vcu, g = item & 31, dir = (item >> 5) & 1, b = item >> 6, p = F.lane; const int gi = dir * 32 + g;
    const float dt = expf(FIN(19)[gi]); const float lre = fminf(FIN(13)[gi * 64 + p], -1e-4f), lim = FIN(14)[gi * 64 + p];
    const float e = expf(lre * dt * (float)S5T); float sn, cs; sincosf(lim * dt * (float)S5T, &sn, &cs); const float lr = e * cs, li = e * sn;
    const float* SS = (const float*)(F.ws + WS_REG + R0_SS) + (size_t)g * NCH_PAD * 256 + dir * 128 + 2 * p;
    bf16* UA = (bf16*)(F.ws + WS_REG + R0_UA) + (size_t)g * NCH_PAD * S5K + 512 + dir * 128 + 2 * p;
    constexpr int NC = NCH_CTX / 2, NL = NCH_LAT / 2;
    float hr = 0.f, hi = 0.f;
    auto chunk_of = [&](int n) { return dir == 0 ? (n < NC ? NCH_LAT + b * NC + n : b * NL + (n - NC)) : (n < NC ? NCH_LAT + b * NC + (NC - 1 - n) : b * NL + (NL - 1 - (n - NC))); };
    for (int n0 = 0; n0 < NC + NL; n0 += 8) {
        float sr[8], si[8]; int ch[8];
#pragma unroll
        for (int q = 0; q < 8; ++q) { ch[q] = chunk_of(n0 + q); const float2 sv = *(const float2*)(SS + (size_t)ch[q] * 256); sr[q] = sv.x; si[q] = sv.y; }
#pragma unroll
        for (int q = 0; q < 8; ++q) { *(unsigned*)(UA + (size_t)ch[q] * S5K) = pk2(hr, hi);
            const float nr = lr * hr - li * hi + sr[q], ni = lr * hi + li * hr + si[q]; hr = nr; hi = ni; }
    }
}
__device__ __forceinline__ void attn0_phase(Frame& F) {
    using namespace attn_body;
    const __hip_bfloat16* QB = (const __hip_bfloat16*)(F.ws + WS_REG + R_QB); const __hip_bfloat16* KB = (const __hip_bfloat16*)(F.ws + WS_REG + R0_KB); const __hip_bfloat16* VB = (const __hip_bfloat16*)(F.ws + WS_REG + R0_VB);
    __hip_bfloat16* CAT = (__hip_bfloat16*)(F.ws + WS_REG + R_CAT); char* shm = (char*)F.lds;
    const int upc = 512 / F.G;
    for (int i = 0; i < upc; ++i) { const int uid = F.vcu * upc + i; const int bk = uid >> 7, w = uid & 127; const int b = bk >> 1, kvh = bk & 1, h = kvh * 4 + (w >> 5), qb = w & 31;
        const size_t qrow = (size_t)b * SEQ + qb * 256;
        attn_unit<0, 8>(QB + qrow * 512 + h * 64, 512, KB + (size_t)b * KVROWS * 128 + kvh * 64, VB + (size_t)b * KVROWS * 128 + kvh * 64, 128, CAT + qrow * 1024 + 512 + h * 64, 1024, KVROWS / 64, 0, 0, -INFINITY, shm, F.tid); }
    if ((F.vcu & 15) == 0 && (F.vcu >> 4) < 16) { const int idx = F.vcu >> 4, b = idx >> 3, h = idx & 7, kvh = h >> 2; const size_t qrow = (size_t)NLAT + b * CTX;
        attn_unit<0, 8>(QB + qrow * 512 + h * 64, 512, KB + (size_t)b * KVROWS * 128 + kvh * 64, VB + (size_t)b * KVROWS * 128 + kvh * 64, 128, CAT + qrow * 1024 + 512 + h * 64, 1024, CTX / 64, 0, 0, -INFINITY, shm, F.tid); }
}
__device__ __forceinline__ void attn1_phase(Frame& F, const Args& A) {
    using namespace attn_body;
    const __hip_bfloat16* QB = (const __hip_bfloat16*)(F.ws + WS_REG + R_QB); const __hip_bfloat16* KB = (const __hip_bfloat16*)(F.ws + WS_REG + R1_KB); const __hip_bfloat16* VB = (const __hip_bfloat16*)(F.ws + WS_REG + R1_VB);
    __hip_bfloat16* CAT = (__hip_bfloat16*)(F.ws + WS_REG + R_CAT); char* shm = (char*)F.lds;
    const int upc = 1024 / F.G;
    for (int i = 0; i < upc; ++i) { const int uid = F.vcu * upc + i; const int bk = uid >> 7, w = uid & 127; const int b = bk >> 2, kvh = bk & 3, h = kvh * 4 + (w >> 5), qb = w & 31;
        const int q0 = qb * 256; const int loc0 = q0 - 128 < 0 ? 0 : q0 - 128, loc1 = q0 + 384 > SEQ ? SEQ : q0 + 384; const int NT = 4 + (loc1 - loc0) / 64;
        const size_t qrow = (size_t)b * SEQ + q0;
        attn_unit<1, 8>(QB + qrow * 1024 + h * 64, 1024, KB + (size_t)b * KVROWS * 256 + kvh * 64, VB + (size_t)b * KVROWS * 256 + kvh * 64, 256, CAT + qrow * 1024 + h * 64, 1024, NT, CTX + loc0, loc0 - q0,
                        FIN(23)[h] * 1.4426950408889634f, shm, F.tid); }
}

__device__ __forceinline__ void run_op(Frame& F, const Args& A, int op, int p0, int p1, int p2) {
    using namespace pg8;
    float* MOD = (float*)(F.ws + WS_MOD); float* XC = (float*)(F.ws + WS_XC);
    bf16* HN = (bf16*)(F.ws + WS_HN); bf16* ACT = (bf16*)(F.ws + WS_REG + R_ACT); bf16* CAT = (bf16*)(F.ws + WS_REG + R_CAT);
    LAS unsigned char* ring = F.lds;
    const int bx = blockIdx.x;
    switch (op) {
    case OP_PROLOGUE: {
        prologue_mod(F, A);
        if (F.vcu >= F.G - 64) { const int item = F.G - 1 - F.vcu; prologue_s5_item(F, A, item & 31, item >> 5); }
        if (F.vcu == F.G / 2) prologue_rope(F, A);
        __syncthreads();
        prologue_transposes(F, A);
    } break;
    case OP_NORM: { const int l = p0, s = p1, nrows = p2 & 0xfffff, first = p2 >> 20;
        norm_phase(F, first ? FIN(0) : F.out, first ? FIN(2) : XC, FIN(6) + ((size_t)l * 3 + s) * D, MOD + (size_t)l * 3 * NMOD, s, nrows);
    } break;
    case OP_FFNA: { Gemm g{HN, (const bf16*)(F.ws + WS_W1T + p0 * W1T_ONE), D, D, D}; TileOrder S; S.init(p1, 2 * DFF / 256, F.G, bx, 0);
        EpiSwiglu E{ACT, DFF}; gemm_phase<EpiSwiglu, TileOrder, true>(ring, F.tid, g, S, E);
    } break;
    case OP_FFNB: { const int lw = p0, l = p1 >> 4, s = p1 & 15, nMt = p2 & 0xfffff, first = p2 >> 20;
        Gemm g{ACT, (const bf16*)(F.ws + WS_W2T + lw * W2T_ONE), DFF, DFF, DFF}; TileOrder S; S.init(nMt, D / 256, F.G, bx, 0);
        EpiResid E{first ? FIN(0) : F.out, first ? FIN(2) : XC, F.out, XC, MOD + (size_t)l * 3 * NMOD + (3 * s + 2) * D, 0.5f}; gemm_phase<EpiResid, TileOrder, true>(ring, F.tid, g, S, E);
    } break;
    case OP_WOUT: { const int l = p0, nMt = p1;
        Gemm g{CAT, (const bf16*)(F.ws + WS_WOUT) + (size_t)l * D * D, D, D, D}; TileOrder S; S.init(nMt, D / 256, F.G, bx, 0);
        EpiResid E{F.out, XC, F.out, XC, MOD + (size_t)l * 3 * NMOD + 5 * D, 1.0f}; gemm_phase<EpiResid, TileOrder, true>(ring, F.tid, g, S, E);
    } break;
    case OP_INAB: { Gemm g{HN, (const bf16*)(F.ws + WS_WINAB), D, D, D}; TileOrder S; S.init(MALL / 256, 5, F.G, bx, 0);
        EpiIn E{0, (bf16*)(F.ws + WS_REG + R0_UA), (bf16*)(F.ws + WS_REG + R_QB), 512, (bf16*)(F.ws + WS_REG + R0_KB), (bf16*)(F.ws + WS_REG + R0_VB), 128, FIN(11), (const float*)(F.ws + WS_ROPE)};
        gemm_phase<EpiIn, TileOrder, true>(ring, F.tid, g, S, E);
    } break;
    case OP_INWIN: { Gemm g{HN, (const bf16*)(F.ws + WS_WINW), D, D, D}; TileOrder S; S.init(MALL / 256, 6, F.G, bx, 0);
        EpiIn E{1, nullptr, (bf16*)(F.ws + WS_REG + R_QB), 1024, (bf16*)(F.ws + WS_REG + R1_KB), (bf16*)(F.ws + WS_REG + R1_VB), 256, FIN(11) + 2 * HD, (const float*)(F.ws + WS_ROPE)};
        gemm_phase<EpiIn, TileOrder, true>(ring, F.tid, g, S, E);
    } break;
    case OP_S5STATE: { Gemm g{(const bf16*)(F.ws + WS_REG + R0_UA), (const bf16*)(F.ws + WS_FS), S5K, 512, 512}; GroupOrder S{3, 1, 3, F.G, F.vcu};
        EpiS5State E{(float*)(F.ws + WS_REG + R0_SS)}; gemm_phase<EpiS5State, GroupOrder, true>(ring, F.tid, g, S, E);
    } break;
    case OP_S5SCAN: s5_scan_phase(F, A); break;
    case OP_S5OUT: { Gemm g{(const bf16*)(F.ws + WS_REG + R0_UA), (const bf16*)(F.ws + WS_OUTM), S5K, S5K, S5K}; GroupOrder S{3, 2, 3, F.G, F.vcu};
        EpiS5Out E{(bf16*)(F.ws + WS_REG + R0_G5)}; gemm_phase<EpiS5Out, GroupOrder, true>(ring, F.tid, g, S, E);
    } break;
    case OP_GLU: { Gemm g{(const bf16*)(F.ws + WS_REG + R0_G5), (const bf16*)(F.ws + WS_GLUT), 512, 512, 512}; TileOrder S; S.init(MALL / 256, 4, F.G, bx, 0);
        EpiGlu E{CAT, 1024}; gemm_phase<EpiGlu, TileOrder, true>(ring, F.tid, g, S, E);
    } break;
    case OP_ATTN0: attn0_phase(F); break;
    case OP_ATTN1: attn1_phase(F, A); break;
    default: break;
    }
}

#define T66 (MALL / 256)
#define T64 (NLAT / 256)
#define FIRST (1 << 20)
__device__ const int PROGRAM[][4] = {
    {OP_PROLOGUE, 0, 0, 0},
    {OP_NORM, 0, 0, MALL | FIRST}, {OP_FFNA, 0, T66, 0}, {OP_FFNB, 0, 0 * 16 + 0, T66 | FIRST},
    {OP_NORM, 0, 1, MALL}, {OP_INAB, 0, 0, 0},
    {OP_S5STATE, 0, 0, 0}, {OP_S5SCAN, 0, 0, 0}, {OP_S5OUT, 0, 0, 0}, {OP_GLU, 0, 0, 0}, {OP_ATTN0, 0, 0, 0},
    {OP_WOUT, 0, T66, 0},
    {OP_NORM, 0, 2, MALL}, {OP_FFNA, 1, T66, 0}, {OP_FFNB, 1, 0 * 16 + 2, T66},
    {OP_NORM, 1, 0, MALL}, {OP_FFNA, 2, T66, 0}, {OP_FFNB, 2, 1 * 16 + 0, T66},
    {OP_NORM, 1, 1, MALL}, {OP_INWIN, 0, 0, 0}, {OP_ATTN1, 0, 0, 0},
    {OP_WOUT, 1, T64, 0},
    {OP_NORM, 1, 2, NLAT}, {OP_FFNA, 3, T64, 0}, {OP_FFNB, 3, 1 * 16 + 2, T64},
};
constexpr int N_OPS = sizeof(PROGRAM) / sizeof(PROGRAM[0]);

__global__ void __launch_bounds__(NWAVES * 64, 2) mega(Args A) {
    extern __shared__ __attribute__((aligned(16))) unsigned char lds_raw[];
    for (int k = A.k_lo; k < A.k_hi; ++k) {
        int tid = threadIdx.x; asm volatile("" : "+v"(tid)); size_t zoff = 0; asm volatile("" : "+s"(zoff)); unsigned char* wsp = A.ws + zoff; float* outp = A.out + zoff;
        Frame F; F.lds = (LAS unsigned char*)lds_raw; F.tid = tid; F.lane = tid & 63; F.wave = __builtin_amdgcn_readfirstlane(tid >> 6);
        F.G = gridDim.x; { const int bx = blockIdx.x; F.vcu = (F.G % 8 == 0) ? (bx % 8) * (F.G / 8) + bx / 8 : bx; }
        F.out = outp; F.ws = wsp;
        const int op = __builtin_amdgcn_readfirstlane(PROGRAM[k][0]), p0 = __builtin_amdgcn_readfirstlane(PROGRAM[k][1]), p1 = __builtin_amdgcn_readfirstlane(PROGRAM[k][2]), p2 = __builtin_amdgcn_readfirstlane(PROGRAM[k][3]);
        run_op(F, A, op, p0, p1, p2);
        if (k + 1 < A.k_hi) { __syncthreads(); cg::this_grid().sync(); }
    }
}

#ifndef MK_ONE_LAUNCH
#define MK_ONE_LAUNCH 0
#endif
extern "C" void kernel_launch(void* const* d_in, const int* in_sizes, int n_in, void* d_out, int out_size, void* d_ws, size_t ws_size, hipStream_t stream) {
    static int grid = 0;
    if (grid == 0) {
        int dev = 0, cus = 0;
        if (hipGetDevice(&dev) != hipSuccess || hipDeviceGetAttribute(&cus, hipDeviceAttributeMultiprocessorCount, dev) != hipSuccess) { grid = -1; return; }
        if (hipFuncSetAttribute((const void*)mega, hipFuncAttributeMaxDynamicSharedMemorySize, LDS_BYTES) != hipSuccess) { fprintf(stderr, "hipFuncSetAttribute failed\n"); grid = -1; return; }
        int per_cu = 0; (void)hipOccupancyMaxActiveBlocksPerMultiprocessor(&per_cu, (const void*)mega, NWAVES * 64, LDS_BYTES); (void)hipGetLastError();
        if (cus < 256 || per_cu < 1 || n_in != 24 || ws_size < WS_END) { fprintf(stderr, "kernel_launch: unsupported device/workspace (cus %d, per_cu %d, ws %zu need %zu)\n", cus, per_cu, ws_size, (size_t)WS_END); grid = -1; return; }
        grid = 256;
    }
    if (grid < 0) return;
    Args a{};
    for (int i = 0; i < 24; ++i) a.in[i] = (const float*)d_in[i];
    a.out = (float*)d_out; a.ws = (unsigned char*)d_ws;
#if MK_ONE_LAUNCH
    a.k_lo = 0; a.k_hi = N_OPS;
    void* kargs[] = {&a};
    hipError_t e = hipLaunchCooperativeKernel((const void*)mega, dim3(grid), dim3(NWAVES * 64), kargs, LDS_BYTES, stream);
    if (e != hipSuccess) fprintf(stderr, "cooperative launch failed: %s\n", hipGetErrorString(e));
#else
    for (int k = 0; k < N_OPS; ++k) { a.k_lo = k; a.k_hi = k + 1; hipLaunchKernelGGL(mega, dim3(grid), dim3(NWAVES * 64), LDS_BYTES, stream, a); }
#endif
}
```

```cpp
#include <hip/hip_runtime.h>
#include <hip/hip_bf16.h>
#include <hip/hip_cooperative_groups.h>
#include <cstdio>
#include <cstdint>
#include <cmath>
#define MK_ONE_LAUNCH 1
namespace pg8 {
#define PG8_LAS __attribute__((address_space(3)))
typedef unsigned short bf16_t;
typedef short bf16x8 __attribute__((ext_vector_type(8)));
typedef float f32x4 __attribute__((ext_vector_type(4)));
typedef float f32x2 __attribute__((ext_vector_type(2)));
typedef unsigned u32x4 __attribute__((ext_vector_type(4)));
constexpr int BM = 256, BK = 64, HALF = 128, HTB = HALF * BK * 2  , STAGE_BYTES = 8 * HTB, NXCD = 8, WGM = 8;

__host__ __device__ __forceinline__ int lds_byte(int r, int c) { const int st = (r >> 4) * 2 + (c >> 5), rr = r & 15, cc = c & 31, ob = rr * 64 + cc * 2; return st * 1024 + (ob ^ (((ob >> 9) & 1) << 5)); }
__host__ __device__ __forceinline__ void stage_rc(int b, int& R, int& C) { const int st = b / 1024, sb = b % 1024, swz = sb ^ (((sb >> 9) & 1) << 5); R = (st >> 1) * 16 + swz / 64; C = (st & 1) * 32 + (swz % 64) / 2; }
__host__ __device__ __forceinline__ int perm32(int rho) { const int n = rho >> 4, i = rho & 15; return 8 * (i >> 2) + 4 * n + (i & 3); }

struct Unit { int pm, pn; };
struct Gemm { const bf16_t* A; const bf16_t* Bt; int lda, ldb, K; };

struct TileOrder {
    int nM, nN, nwg, G, c, pm0;
    __device__ void init(int nM_, int nN_, int G_, int c_, int pm0_) { nM = nM_; nN = nN_; nwg = nM * nN; G = G_; c = c_; pm0 = pm0_; }
    __device__ bool next(int i, Unit& u) const {
        const long L = (long)i * G + c; if (L >= nwg) return false;
        int wgid = (int)L; { const int q = nwg / NXCD, r = nwg % NXCD, xcd = wgid % NXCD, off = wgid / NXCD; wgid = (xcd < r ? xcd * (q + 1) : r * (q + 1) + (xcd - r) * q) + off; }
        const int nig = WGM * nN, gid = wgid / nig, fm = gid * WGM, gsz = (nM - fm) < WGM ? (nM - fm) : WGM;
        u.pm = pm0 + fm + ((wgid % nig) % gsz); u.pn = (wgid % nig) / gsz; return true;
    }
};
struct GroupOrder {
    int nMt, nNt, aStride, G, c;
    __device__ bool next(int i, Unit& u) const {
        const int L = i * G + c, per = nMt * nNt; if (L >= 32 * per) return false;
        const int g = L / per, r = L % per, mt = r / nNt, nt = r % nNt;
        u.pm = g * aStride + mt; u.pn = g * nNt + nt; return true;
    }
};

__device__ __forceinline__ unsigned cvt_pk_bf16(float lo, float hi) { unsigned r; asm volatile("v_cvt_pk_bf16_f32 %0, %1, %2" : "=v"(r) : "v"(lo), "v"(hi)); return r; }
__device__ __forceinline__ float fast_sigmoid(float x) { return __builtin_amdgcn_rcpf(1.f + __builtin_amdgcn_exp2f(-1.4426950408889634f * x)); }
__device__ __forceinline__ u32x4 pack8(const f32x4 a, const f32x4 b) { u32x4 w; w.x = cvt_pk_bf16(a[0], a[1]); w.y = cvt_pk_bf16(a[2], a[3]); w.z = cvt_pk_bf16(b[0], b[1]); w.w = cvt_pk_bf16(b[2], b[3]); return w; }

typedef f32x4 Acc[2][2][4][2];

template <class Epi, class Sched, bool ALIGN_EPI>
__device__ __forceinline__ void gemm_phase(PG8_LAS unsigned char* lds, const int tid, const Gemm g, const Sched& S, const Epi& E) {
    const int wid = __builtin_amdgcn_readfirstlane(tid >> 6), lane = tid & 63, wr = wid >> 2, wc = wid & 3, fr = lane & 15, fq = lane >> 4;
    const int K = g.K, nt = K / BK;
    unsigned voffA[2], voffB[2];
#pragma unroll
    for (int i = 0; i < 2; ++i) { int R, C; stage_rc(tid * 16 + i * 8192, R, C); const int Rb = Epi::PERM ? ((R & ~31) + perm32(R & 31)) : R;
        voffA[i] = (unsigned)(R * g.lda + C) * 2u; voffB[i] = (unsigned)(Rb * g.ldb + C) * 2u; }
    const size_t kstep = (size_t)(BK * 2);
    const size_t hstepA = (size_t)HALF * g.lda * 2, hstepB = (size_t)HALF * g.ldb * 2, tstepA = 2 * hstepA, tstepB = 2 * hstepB;
    const unsigned ldsw = (unsigned)wid * 1024u;
    const int aoff = lds_byte(wr * 64 + fr, fq * 8), boff = lds_byte(wc * 32 + fr, fq * 8);
#define PG8_SA(b, h) (((b) * 2 + (h)) * HTB)
#define PG8_SB(b, h) ((4 + (b) * 2 + (h)) * HTB)
#define PG8_STAGE(bufoff, gbase, voff) do { _Pragma("unroll") for (int _i = 0; _i < 2; ++_i) \
        __builtin_amdgcn_global_load_lds((const unsigned*)((const char*)(gbase) + (voff)[_i]), (PG8_LAS unsigned*)(lds + (bufoff) + ldsw + _i * 8192), 16, 0, 0); } while (0)
#define PG8_LDA(dst, b, h) do { _Pragma("unroll") for (int m = 0; m < 4; ++m) _Pragma("unroll") for (int k = 0; k < 2; ++k) dst[m][k] = *(const PG8_LAS bf16x8*)(lds + PG8_SA(b, h) + aoff + m * 2048 + k * 1024); } while (0)
#define PG8_LDB(dst, b, h) do { _Pragma("unroll") for (int n = 0; n < 2; ++n) _Pragma("unroll") for (int k = 0; k < 2; ++k) dst[n][k] = *(const PG8_LAS bf16x8*)(lds + PG8_SB(b, h) + boff + n * 2048 + k * 1024); } while (0)
#define PG8_MMA(ai, bj, At, Bt) do { __builtin_amdgcn_s_setprio(1); _Pragma("unroll") for (int m = 0; m < 4; ++m) _Pragma("unroll") for (int n = 0; n < 2; ++n) _Pragma("unroll") for (int k = 0; k < 2; ++k) \
        acc[ai][bj][m][n] = __builtin_amdgcn_mfma_f32_16x16x32_bf16(Bt[n][k], At[m][k], acc[ai][bj][m][n], 0, 0, 0); __builtin_amdgcn_s_setprio(0); } while (0)
#define PG8_WAIT_V(n) asm volatile("s_waitcnt vmcnt(" #n ")" ::: "memory")
#define PG8_WAIT_L(n) asm volatile("s_waitcnt lgkmcnt(" #n ")" ::: "memory")
#define PG8_BAR __builtin_amdgcn_s_barrier()
#define PG8_SCHED __builtin_amdgcn_sched_barrier(0)
    Unit cur, nxt; int ui = 0;
    if (!S.next(0, cur)) return;
    f32x4 acc[2][2][4][2];
#pragma unroll
    for (int a = 0; a < 2; ++a)
#pragma unroll
        for (int b = 0; b < 2; ++b)
#pragma unroll
            for (int m = 0; m < 4; ++m)
#pragma unroll
                for (int n = 0; n < 2; ++n) acc[a][b][m][n] = (f32x4){0.f, 0.f, 0.f, 0.f};
    bf16x8 At[4][2], B0[2][2], B1[2][2];
    const char* cA = (const char*)g.A + (size_t)cur.pm * tstepA; const char* cB = (const char*)g.Bt + (size_t)cur.pn * tstepB;
    PG8_STAGE(PG8_SB(0, 0), cB, voffB); PG8_STAGE(PG8_SB(0, 1), cB + hstepB, voffB); PG8_STAGE(PG8_SA(0, 0), cA, voffA); PG8_STAGE(PG8_SA(0, 1), cA + hstepA, voffA);
    if (wr == 1) PG8_BAR;
    PG8_WAIT_V(2); PG8_BAR;
    PG8_STAGE(PG8_SB(1, 0), cB + kstep, voffB); PG8_STAGE(PG8_SA(1, 0), cA + kstep, voffA); PG8_STAGE(PG8_SB(1, 1), cB + hstepB + kstep, voffB);
    PG8_WAIT_V(6); PG8_BAR;
    for (;;) {
        const bool has_next = S.next(ui + 1, nxt);
        const char* nA = has_next ? (const char*)g.A + (size_t)nxt.pm * tstepA : cA; const char* nB = has_next ? (const char*)g.Bt + (size_t)nxt.pn * tstepB : cB;
        for (int t = 0; t < nt; t += 2) {
            const bool last = (t == nt - 2);
            const char* a1 = cA + (size_t)(t + 1) * kstep;
            const char* a2 = last ? nA : cA + (size_t)(t + 2) * kstep; const char* b2 = last ? nB : cB + (size_t)(t + 2) * kstep;
            const char* a3 = a2 + kstep; const char* b3 = b2 + kstep;
            PG8_LDB(B0, 0, 0); PG8_LDB(B1, 0, 1); PG8_SCHED; PG8_LDA(At, 0, 0); PG8_STAGE(PG8_SA(1, 1), a1 + hstepA, voffA);
            PG8_WAIT_V(8); PG8_WAIT_L(0); PG8_BAR; PG8_MMA(0, 0, At, B0); PG8_MMA(0, 1, At, B1); PG8_BAR; PG8_SCHED;
            PG8_LDA(At, 0, 1); PG8_STAGE(PG8_SB(0, 0), b2, voffB); PG8_STAGE(PG8_SB(0, 1), b2 + hstepB, voffB); PG8_STAGE(PG8_SA(0, 0), a2, voffA);
            PG8_WAIT_V(8); PG8_WAIT_L(0); PG8_BAR; PG8_MMA(1, 0, At, B0); PG8_MMA(1, 1, At, B1); PG8_BAR; PG8_SCHED;
            PG8_LDB(B0, 1, 0); PG8_LDB(B1, 1, 1); PG8_SCHED; PG8_LDA(At, 1, 0); PG8_STAGE(PG8_SA(0, 1), a2 + hstepA, voffA);
            PG8_WAIT_V(8); PG8_WAIT_L(0); PG8_BAR; PG8_MMA(0, 0, At, B0); PG8_MMA(0, 1, At, B1); PG8_BAR; PG8_SCHED;
            PG8_LDA(At, 1, 1); PG8_STAGE(PG8_SB(1, 0), b3, voffB); PG8_STAGE(PG8_SB(1, 1), b3 + hstepB, voffB); PG8_STAGE(PG8_SA(1, 0), a3, voffA);
            PG8_WAIT_V(8); PG8_WAIT_L(0); PG8_BAR; PG8_MMA(1, 0, At, B0); PG8_MMA(1, 1, At, B1); PG8_BAR; PG8_SCHED;
        }
        if constexpr (ALIGN_EPI) { if (wr == 0) PG8_BAR; }
        E(acc, cur, wr, wc, fr, fq);
        if (!has_next) break;
#pragma unroll
        for (int a = 0; a < 2; ++a)
#pragma unroll
            for (int b = 0; b < 2; ++b)
#pragma unroll
                for (int m = 0; m < 4; ++m)
#pragma unroll
                    for (int n = 0; n < 2; ++n) acc[a][b][m][n] = (f32x4){0.f, 0.f, 0.f, 0.f};
        cur = nxt; cA = nA; cB = nB; ++ui;
        if constexpr (ALIGN_EPI) { if (wr == 1) PG8_BAR; }
    }
    PG8_WAIT_V(0);
    if constexpr (!ALIGN_EPI) { if (wr == 0) PG8_BAR; }
    PG8_BAR;
#undef PG8_SA
#undef PG8_SB
#undef PG8_STAGE
#undef PG8_LDA
#undef PG8_LDB
#undef PG8_MMA
#undef PG8_WAIT_V
#undef PG8_WAIT_L
#undef PG8_BAR
#undef PG8_SCHED
}
}
namespace cfg {
constexpr int D = 1024, BATCH = 2, SEQ = 8192, CTX = 256, HD = 64, DFF = 2816;
constexpr int NLAT = BATCH * SEQ, NCTX = BATCH * CTX, MALL = NLAT + NCTX;
constexpr int NMOD = 9 * D;
constexpr float EPS = 1e-6f;
constexpr int KVROWS = CTX + SEQ;
constexpr int S5T = 32;
constexpr int S5K = S5T * 16 + 256;
constexpr int NCH_LAT = NLAT / S5T, NCH_CTX = NCTX / S5T, NCH = NCH_LAT + NCH_CTX, NCH_PAD = 768;
constexpr float C2 = 0.125f * 1.4426950408889634f;
}

namespace pg8 {
using namespace cfg;
struct EpiSwiglu { static constexpr bool PERM = true; bf16_t* O; int ldo;
    __device__ __forceinline__ void operator()(const Acc& acc, const Unit& u, int wr, int wc, int fr, int fq) const {
        const int row0 = u.pm * BM + wr * 64 + fr, col0 = u.pn * 128 + wc * 32 + 8 * fq;
#pragma unroll
        for (int ai = 0; ai < 2; ++ai)
#pragma unroll
            for (int m = 0; m < 4; ++m) { f32x4 v[2];
#pragma unroll
                for (int n = 0; n < 2; ++n) { const f32x4 gg = acc[ai][0][m][n], uu = acc[ai][1][m][n];
#pragma unroll
                    for (int j = 0; j < 4; ++j) v[n][j] = gg[j] * fast_sigmoid(gg[j]) * uu[j]; }
                *(u32x4*)(O + (size_t)(row0 + ai * HALF + m * 16) * ldo + col0) = pack8(v[0], v[1]); }
    }
};
struct EpiGlu { static constexpr bool PERM = true; bf16_t* O; int ldo;
    __device__ __forceinline__ void operator()(const Acc& acc, const Unit& u, int wr, int wc, int fr, int fq) const {
        const int row0 = u.pm * BM + wr * 64 + fr, col0 = u.pn * 128 + wc * 32 + 8 * fq;
#pragma unroll
        for (int ai = 0; ai < 2; ++ai)
#pragma unroll
            for (int m = 0; m < 4; ++m) { f32x4 v[2];
#pragma unroll
                for (int n = 0; n < 2; ++n) { const f32x4 aa = acc[ai][0][m][n], bb = acc[ai][1][m][n];
#pragma unroll
                    for (int j = 0; j < 4; ++j) v[n][j] = aa[j] * fast_sigmoid(bb[j]); }
                *(u32x4*)(O + (size_t)(row0 + ai * HALF + m * 16) * ldo + col0) = pack8(v[0], v[1]); }
    }
};
struct EpiResid { static constexpr bool PERM = false; const float* baseL; const float* baseC; float* outL; float* outC; const float* gate; float coef;
    __device__ __forceinline__ void operator()(const Acc& acc, const Unit& u, int wr, int wc, int fr, int fq) const {
        const int src = u.pm < 32 ? 0 : (u.pm < 64 ? 1 : 2);
        const float* gt = gate + (size_t)src * NMOD;
        const float* base = u.pm < 64 ? baseL + (size_t)u.pm * BM * D : baseC + (size_t)(u.pm - 64) * BM * D;
        float* out = u.pm < 64 ? outL + (size_t)u.pm * BM * D : outC + (size_t)(u.pm - 64) * BM * D;
        const int col0 = u.pn * BM + wc * 32 + 4 * fq;
        f32x4 gv[2][2];
#pragma unroll
        for (int bj = 0; bj < 2; ++bj)
#pragma unroll
            for (int n = 0; n < 2; ++n) gv[bj][n] = *(const f32x4*)(gt + col0 + bj * HALF + n * 16) * coef;
#pragma unroll
        for (int ai = 0; ai < 2; ++ai)
#pragma unroll
            for (int m = 0; m < 4; ++m) { const size_t off = (size_t)(wr * 64 + fr + ai * HALF + m * 16) * D + col0;
#pragma unroll
                for (int bj = 0; bj < 2; ++bj)
#pragma unroll
                    for (int n = 0; n < 2; ++n) { const f32x4 b = *(const f32x4*)(base + off + bj * HALF + n * 16); *(f32x4*)(out + off + bj * HALF + n * 16) = b + gv[bj][n] * acc[ai][bj][m][n]; } }
    }
};
struct EpiIn { static constexpr bool PERM = true;
    int mode;
    bf16_t* UA; bf16_t* QB; int qp; bf16_t* KB; bf16_t* VB; int kp; const float* qkg; const float* rope;
    __device__ __forceinline__ void operator()(const Acc& acc, const Unit& u, int wr, int wc, int fr, int fq) const {
        int role, head;
        if (mode == 0) { if (u.pn < 2) { role = 0; head = 0; } else if (u.pn < 4) { role = 1; head = 4 * (u.pn - 2) + wc; } else { role = (wc < 2) ? 2 : 3; head = wc & 1; } }
        else { if (u.pn < 4) { role = 1; head = 4 * u.pn + wc; } else if (u.pn == 4) { role = 2; head = wc; } else { role = 3; head = wc; } }
        const bool isctx = u.pm >= 64;
        if (role == 1 && isctx && mode == 1) return;
        const int rbase = u.pm * BM + wr * 64 + fr;
        if (role == 0) {
#pragma unroll
            for (int ai = 0; ai < 2; ++ai)
#pragma unroll
                for (int m = 0; m < 4; ++m) { const int R = rbase + ai * HALF + m * 16; const int ch = isctx ? NCH_LAT + ((R - NLAT) >> 5) : (R >> 5); const int s = R & 31;
#pragma unroll
                    for (int bj = 0; bj < 2; ++bj) { const int cu = u.pn * BM + bj * HALF + wc * 32 + 8 * fq; const int g = cu >> 4, j0 = cu & 15;
                        *(u32x4*)(UA + ((size_t)(g * NCH_PAD + ch) * S5K + s * 16 + j0)) = pack8(acc[ai][bj][m][0], acc[ai][bj][m][1]); } }
            return;
        }
        f32x4 glo[2], ghi[2];
        if (role != 3) { const float* gp = qkg + (role == 1 ? 0 : HD) + 8 * fq; glo[0] = *(const f32x4*)gp; glo[1] = *(const f32x4*)(gp + 4); ghi[0] = *(const f32x4*)(gp + 32); ghi[1] = *(const f32x4*)(gp + 36); }
        const float qs = (role == 1) ? C2 : 1.f;
#pragma unroll
        for (int ai = 0; ai < 2; ++ai)
#pragma unroll
            for (int m = 0; m < 4; ++m) { const int R = rbase + ai * HALF + m * 16;
                int b, t; if (isctx) { b = (R - NLAT) >> 8; t = (R - NLAT) & 255; } else { b = R >> 13; t = R & 8191; }
                f32x4 lo[2] = {acc[ai][0][m][0], acc[ai][0][m][1]}, hi[2] = {acc[ai][1][m][0], acc[ai][1][m][1]};
                if (role != 3) {
                    float ss = 0.f;
#pragma unroll
                    for (int n = 0; n < 2; ++n)
#pragma unroll
                        for (int j = 0; j < 4; ++j) ss += lo[n][j] * lo[n][j] + hi[n][j] * hi[n][j];
                    ss += __shfl_xor(ss, 16); ss += __shfl_xor(ss, 32);
                    const float rs = rsqrtf(ss * (1.f / HD) + EPS) ;
#pragma unroll
                    for (int n = 0; n < 2; ++n) { lo[n] = lo[n] * rs * glo[n]; hi[n] = hi[n] * rs * ghi[n]; }
                    if (!isctx) {
                        const int pos = (fq < 2) ? (t >> 6) : (t & 63); const float* rp = rope + pos * 32 + 8 * (fq & 1);
#pragma unroll
                        for (int n = 0; n < 2; ++n) { const f32x4 cs = *(const f32x4*)(rp + 4 * n), sn = *(const f32x4*)(rp + 16 + 4 * n);
                            const f32x4 x1 = lo[n], x2 = hi[n]; lo[n] = x1 * cs - x2 * sn; hi[n] = x1 * sn + x2 * cs; }
                    }
#pragma unroll
                    for (int n = 0; n < 2; ++n) { lo[n] = lo[n] * qs; hi[n] = hi[n] * qs; }
                }
                bf16_t* dst;
                if (role == 1) dst = QB + (size_t)R * qp + head * HD + 8 * fq;
                else { const size_t kr = (size_t)b * KVROWS + (isctx ? t : CTX + t); dst = (role == 2 ? KB : VB) + kr * kp + head * HD + 8 * fq; }
                *(u32x4*)dst = pack8(lo[0], lo[1]); *(u32x4*)(dst + 32) = pack8(hi[0], hi[1]);
            }
    }
};
struct EpiS5State { static constexpr bool PERM = false; float* SS;
    __device__ __forceinline__ void operator()(const Acc& acc, const Unit& u, int wr, int wc, int fr, int fq) const {
        const int mt = u.pm % 3; const int col0 = wc * 32 + 4 * fq;
#pragma unroll
        for (int ai = 0; ai < 2; ++ai)
#pragma unroll
            for (int m = 0; m < 4; ++m) { const int rl = wr * 64 + fr + ai * HALF + m * 16; if (mt * BM + rl >= NCH) continue;
                float* rowp = SS + (size_t)(u.pm * BM + rl) * 256 + col0;
#pragma unroll
                for (int bj = 0; bj < 2; ++bj)
#pragma unroll
                    for (int n = 0; n < 2; ++n) *(f32x4*)(rowp + bj * HALF + n * 16) = acc[ai][bj][m][n]; }
    }
};
struct EpiS5Out { static constexpr bool PERM = true; bf16_t* G5;
    __device__ __forceinline__ void operator()(const Acc& acc, const Unit& u, int wr, int wc, int fr, int fq) const {
        const int g = u.pm / 3, mt = u.pm % 3, ntile = u.pn & 1;
#pragma unroll
        for (int ai = 0; ai < 2; ++ai)
#pragma unroll
            for (int m = 0; m < 4; ++m) { const int ch = mt * BM + wr * 64 + fr + ai * HALF + m * 16; if (ch >= NCH) continue;
                const int rowbase = ch < NCH_LAT ? ch * S5T : NLAT + (ch - NCH_LAT) * S5T;
#pragma unroll
                for (int bj = 0; bj < 2; ++bj) { const int nn = ntile * BM + bj * HALF + wc * 32 + 8 * fq; const int t = nn >> 4, i0 = nn & 15;
                    f32x4 v[2];
#pragma unroll
                    for (int n = 0; n < 2; ++n)
#pragma unroll
                        for (int j = 0; j < 4; ++j) { const float y = acc[ai][bj][m][n][j]; v[n][j] = y * fast_sigmoid(1.5957691216057308f * (y + 0.044715f * y * y * y)); }
                    *(u32x4*)(G5 + (size_t)(rowbase + t) * 512 + g * 16 + i0) = pack8(v[0], v[1]); } }
    }
};
}
namespace attn_body {
using bf16=__hip_bfloat16;
using bf16x8=__attribute__((ext_vector_type(8)))short;
using s16x4=__attribute__((ext_vector_type(4)))short;
using f32x16=__attribute__((ext_vector_type(16)))float;
using u32x4=__attribute__((ext_vector_type(4)))unsigned;
constexpr int D=64;
constexpr int NW=8,QBLK=32,QB=QBLK*NW,KVBLK=64;
__device__ __forceinline__ int crow(int r,int hi){return (r&3)+8*(r>>2)+4*hi;}
#define SBAR() __builtin_amdgcn_sched_barrier(0)
__device__ __forceinline__ void wmask(f32x16&p0,f32x16&p1,int kb0,int qrel,int hi){
  const float NEG=-INFINITY; const int kb=kb0+4*hi-qrel;
  #pragma unroll
  for(int r=0;r<16;++r){const int d=kb+(r&3)+8*(r>>2); if(d>128||d<-128)p0[r]=NEG; if(d+32>128||d+32<-128)p1[r]=NEG;}
}
constexpr int NSLOT=3, SLOTB=8192;
constexpr int LDS_K=0, LDS_V=NSLOT*SLOTB, LDS_WS=2*NSLOT*SLOTB, LDS_OST=LDS_WS+NW*64*4, LDS_BYTES=LDS_OST+NW*4096;
__device__ __forceinline__ void glds16(const void*gsrc,unsigned lds_dst){unsigned keep;
  asm volatile("s_mov_b32 %0, m0\n\ts_mov_b32 m0, %2\n\ts_nop 0\n\tglobal_load_lds_dwordx4 %1, off\n\ts_mov_b32 m0, %0":"=&s"(keep):"v"(gsrc),"s"(lds_dst):"memory");}
__device__ __forceinline__ float max3f(float a,float b,float c){float r;asm("v_max3_f32 %0, %1, %2, %3":"=v"(r):"v"(a),"v"(b),"v"(c));return r;}
__device__ __forceinline__ float max2f(float a,float b){float r;asm("v_max_f32_e32 %0, %1, %2":"=v"(r):"v"(a),"v"(b));return r;}
__device__ __forceinline__ float fadd_s(float a,float b){float r;asm("v_add_f32_e32 %0, %1, %2":"=v"(r):"v"(a),"v"(b));return r;}
__device__ __forceinline__ float fsub_s(float a,float b){float r;asm("v_sub_f32_e32 %0, %1, %2":"=v"(r):"v"(a),"v"(b));return r;}
typedef float f32x2_t __attribute__((ext_vector_type(2))); typedef __bf16 bf16x2_t __attribute__((ext_vector_type(2)));
__device__ __forceinline__ unsigned cvtpk_s(float lo,float hi){f32x2_t v={lo,hi};bf16x2_t b=__builtin_convertvector(v,bf16x2_t);return __builtin_bit_cast(unsigned,b);}
#define WAIT_BAR(N) asm volatile("s_waitcnt vmcnt(" #N ") lgkmcnt(0)\n\ts_barrier":::"memory")

__device__ __forceinline__ void qkt(f32x16&p0,f32x16&p1,const char*Kslot,const bf16x8*qr,const f32x16&negm,int r32,int hi){
  const char*kb=Kslot+hi*1024+r32*16;
  #pragma unroll
  for(int d0=0;d0<4;++d0){
    const bf16x8 b0=*reinterpret_cast<const bf16x8*>(kb+d0*2048);
    const bf16x8 b1=*reinterpret_cast<const bf16x8*>(kb+d0*2048+512);
    if(d0==0){p0=__builtin_amdgcn_mfma_f32_32x32x16_bf16(b0,qr[0],negm,0,0,0);p1=__builtin_amdgcn_mfma_f32_32x32x16_bf16(b1,qr[0],negm,0,0,0);}
    else{p0=__builtin_amdgcn_mfma_f32_32x32x16_bf16(b0,qr[d0],p0,0,0,0);p1=__builtin_amdgcn_mfma_f32_32x32x16_bf16(b1,qr[d0],p1,0,0,0);}}
}
typedef __attribute__((address_space(3))) const char* lds_cptr;
typedef short v4i16_t __attribute__((ext_vector_type(4)));
__device__ __forceinline__ void kload8(bf16x8*kf,lds_cptr kp){
  kf[0]=*(const __attribute__((address_space(3))) bf16x8*)(kp);      kf[1]=*(const __attribute__((address_space(3))) bf16x8*)(kp+512);
  kf[2]=*(const __attribute__((address_space(3))) bf16x8*)(kp+2048); kf[3]=*(const __attribute__((address_space(3))) bf16x8*)(kp+2560);
  kf[4]=*(const __attribute__((address_space(3))) bf16x8*)(kp+4096); kf[5]=*(const __attribute__((address_space(3))) bf16x8*)(kp+4608);
  kf[6]=*(const __attribute__((address_space(3))) bf16x8*)(kp+6144); kf[7]=*(const __attribute__((address_space(3))) bf16x8*)(kp+6656);
}
__device__ __forceinline__ void kload2(bf16x8*kf,lds_cptr kp,int j){ kf[2*j]=*(const __attribute__((address_space(3))) bf16x8*)(kp+j*2048); kf[2*j+1]=*(const __attribute__((address_space(3))) bf16x8*)(kp+j*2048+512); }
__device__ __forceinline__ s16x4 vtr(lds_cptr p){ return __builtin_bit_cast(s16x4,__builtin_amdgcn_ds_read_tr16_b64_v4i16((__attribute__((address_space(3))) v4i16_t*)p)); }
__device__ __forceinline__ float rowmax(const f32x16&p0,const f32x16&p1){
  float a=max3f(p0[0],p0[1],p1[0]),b=max3f(p0[2],p0[3],p1[1]);a=max3f(a,p1[2],p1[3]);
  #pragma unroll
  for(int r=4;r<16;r+=4){a=max3f(a,p0[r],p0[r+1]);b=max3f(b,p0[r+2],p0[r+3]);a=max3f(a,p1[r],p1[r+1]);b=max3f(b,p1[r+2],p1[r+3]);}
  const float m=max2f(a,b);
  auto rr=__builtin_amdgcn_permlane32_swap(__float_as_uint(m),__float_as_uint(m),false,false);
  return max2f(__uint_as_float(rr[0]),__uint_as_float(rr[1]));
}
__device__ __forceinline__ void pv(f32x16*o,int vb,bf16x8 pa0,bf16x8 pa1,bf16x8 pa2,bf16x8 pa3){
  #pragma unroll
  for(int d0=0;d0<2;++d0){s16x4 lo[4],hi[4];
    #pragma unroll
    for(int ks=0;ks<4;++ks){
      asm volatile("ds_read_b64_tr_b16 %0,%1 offset:%c2":"=&v"(lo[ks]):"v"(vb),"i"(d0*4096+ks*1024):"memory");
      asm volatile("ds_read_b64_tr_b16 %0,%1 offset:%c2":"=&v"(hi[ks]):"v"(vb),"i"(d0*4096+ks*1024+512):"memory");}
    asm volatile("s_waitcnt lgkmcnt(0)":::"memory");SBAR();
    #define PK(k) (bf16x8){lo[k][0],lo[k][1],lo[k][2],lo[k][3],hi[k][0],hi[k][1],hi[k][2],hi[k][3]}
    o[d0]=__builtin_amdgcn_mfma_f32_32x32x16_bf16(pa0,PK(0),o[d0],0,0,0);
    o[d0]=__builtin_amdgcn_mfma_f32_32x32x16_bf16(pa1,PK(1),o[d0],0,0,0);
    o[d0]=__builtin_amdgcn_mfma_f32_32x32x16_bf16(pa2,PK(2),o[d0],0,0,0);
    o[d0]=__builtin_amdgcn_mfma_f32_32x32x16_bf16(pa3,PK(3),o[d0],0,0,0);
    #undef PK
  }
}

#ifndef ATTN_STORE16
#define ATTN_STORE16(p,v) (*(u32x4*)(p)=(v))
#endif
template<int MODE,int THRL> __device__ __forceinline__ void attn_unit(const bf16*Qw0,int qp,const bf16*__restrict__ Kh,const bf16*__restrict__ Vh,int kp,bf16*Ow0,int op,int NT,int loc_row0,int krel0,float sink_l2,char*shm,const int tid){
  const int lane=tid&63,r32=lane&31,hi=lane>>5; const int wid=__builtin_amdgcn_readfirstlane(tid>>6);
  const bf16*Qw=Qw0+(long)wid*QBLK*qp;
  const unsigned lds0=(unsigned)(uintptr_t)shm;
  float*wsf=(float*)(shm+LDS_WS)+wid*64;
  const bf16*ksrc=Kh+(long)lane*kp+wid*8;
  const bf16*vsrc=Vh+(long)(16*(wid&3)+(lane>>2))*kp+(wid>>2)*32+(lane&3)*8;
  #define TROW(t) ((MODE==1&&(t)>=4)?(loc_row0+64*((t)-4)):(64*(t)))
  const unsigned kdst=lds0+LDS_K+wid*1024, vdst=lds0+LDS_V+wid*1024;
  #define DMA_K(t,slot) glds16(ksrc+(long)TROW(t)*kp,(unsigned)__builtin_amdgcn_readfirstlane(kdst+(slot)))
  #define DMA_V(t,slot) glds16(vsrc+(long)TROW(t)*kp,(unsigned)__builtin_amdgcn_readfirstlane(vdst+(slot)))
  const int vb0=(int)(lds0+LDS_V)+((lane>>4)&1)*32+(lane&3)*8+(4*hi+((lane&15)>>2))*64;
  const char*Kbase=shm+LDS_K; bf16x8 kf[8];
  const lds_cptr shm3=(lds_cptr)shm; const lds_cptr kp0=shm3+LDS_K+hi*1024+r32*16; const lds_cptr vp0=shm3+LDS_V+((lane>>4)&1)*32+(lane&3)*8+(4*hi+((lane&15)>>2))*64;
  DMA_K(0,0);DMA_V(0,0);DMA_K(1,SLOTB);
  bf16x8 qr[4];
  #pragma unroll
  for(int d0=0;d0<4;++d0)qr[d0]=*reinterpret_cast<const bf16x8*>(&Qw[(long)r32*qp+d0*16+hi*8]);
  float zf=0.f;asm volatile("":"+v"(zf));
  float mhat=0.f,l_reg=0.f;f32x16 o[2];f32x16 negm;
  #pragma unroll
  for(int r=0;r<16;++r){o[0][r]=zf;o[1][r]=zf;negm[r]=zf;}
  asm volatile("":"+v"(negm));
  const int qrel=wid*QBLK+r32;
  #define CMASK(P0,P1,t) do{ if(MODE==1&&(t)>=4) wmask(P0,P1,krel0+64*((t)-4),qrel,hi); }while(0)
  bool resc=false;
  #define START(P0,P1) do{ const float rm=rowmax(P0,P1); resc=false; \
    { const float dl=rm; mhat=fadd_s(mhat,dl); \
      _Pragma("unroll") for(int r=0;r<16;++r){P0[r]=fsub_s(P0[r],dl);P1[r]=fsub_s(P1[r],dl);} \
      _Pragma("unroll") for(int r=0;r<16;++r)negm[r]=-mhat; asm volatile("":"+v"(negm)); } \
    _Pragma("unroll") for(int r=0;r<16;++r)P0[r]=__builtin_amdgcn_exp2f(P0[r]); }while(0)
  #define RESC() do{ if(resc){ asm volatile("s_waitcnt lgkmcnt(0)":::"memory"); \
      _Pragma("unroll") for(int d_=0;d_<2;++d_) _Pragma("unroll") for(int r=0;r<16;++r)o[d_][r]*=wsf[crow(r,hi)]; } }while(0)
  f32x16 pA0,pA1,pB0,pB1;
  int sl_prev=0,sl_cur=0,sl_next=SLOTB;
  #define ROT() do{sl_prev=sl_cur;sl_cur=sl_next;sl_next=(sl_next==(NSLOT-1)*SLOTB)?0:sl_next+SLOTB;}while(0)
  DMA_K(2,2*SLOTB);
  WAIT_BAR(3);
  qkt(pA0,pA1,Kbase,qr,negm,r32,hi);asm volatile("s_nop 15\n\ts_nop 7":"+v"(pA0),"+v"(pA1));CMASK(pA0,pA1,0);
  START(pA0,pA1);
  _Pragma("unroll") for(int r=0;r<16;++r)pA1[r]=__builtin_amdgcn_exp2f(pA1[r]);
  WAIT_BAR(0);
  DMA_K(3,0);DMA_V(1,SLOTB);
  ROT();
  kload8(kf,kp0+sl_cur);
  WAIT_BAR(2);
  s16x4 vlo[8],vhi[8]; u32x4 pw0,pw1,pw2,pw3;
  #define PKW(P,B) cvtpk_s(P[B],P[B+1])
  #define PAF(k) __builtin_bit_cast(bf16x8,pw##k)
  #define VFR(i) (bf16x8){vlo[i][0],vlo[i][1],vlo[i][2],vlo[i][3],vhi[i][0],vhi[i][1],vhi[i][2],vhi[i][3]}
  #define PIN(x) asm volatile("":"+v"(x))
  #define MX3(a,b,c) __builtin_fmaxf(__builtin_fmaxf((a),(b)),(c))
  #define GAPA(MF,A0,A1,A2,A3,W0,W1,PW) do{ MF; sacc+=A0; sacc+=A1; sacc+=A2; sacc+=A3; PIN(sacc); W0; W1; PIN(PW); SBAR(); }while(0)
  #define EX(v) __builtin_amdgcn_exp2f(v)
  #define GAPB(MF,X,B) do{ MF; X[B]=EX(X[B]); X[B+1]=EX(X[B+1]); X[B+2]=EX(X[B+2]); X[B+3]=EX(X[B+3]); PIN(X); SBAR(); }while(0)
  #define VRD(i) do{ vlo[i]=vtr(vp_+(((i)>>2)*4096+((i)&3)*1024)); vhi[i]=vtr(vp_+(((i)>>2)*4096+((i)&3)*1024+512)); }while(0)
  #define KRD(G,j) do{ if(G){ kload2(kf,kp0+sl_next,j); SBAR(); } }while(0)
  #define STEP(C0,C1,P0,P1,t,GK,GV,GL) do{ SBAR(); \
    const lds_cptr vp_=vp0+sl_prev; \
    VRD(0); SBAR(); float sacc=(P0[0]+P0[1]); \
    GAPA(C0=__builtin_amdgcn_mfma_f32_32x32x16_bf16(kf[0],qr[0],negm,0,0,0), P0[2],P0[3],P0[4],P0[5],     pw0[0]=PKW(P0,0), pw0[1]=PKW(P0,2), pw0); \
    VRD(4); SBAR(); GAPA(C1=__builtin_amdgcn_mfma_f32_32x32x16_bf16(kf[1],qr[0],negm,0,0,0), P0[6],P0[7],P0[8],P0[9],     pw0[2]=PKW(P0,4), pw0[3]=PKW(P0,6), pw0); \
    VRD(1); SBAR(); GAPA(C0=__builtin_amdgcn_mfma_f32_32x32x16_bf16(kf[2],qr[1],C0,0,0,0),   P0[10],P0[11],P0[12],P0[13], pw1[0]=PKW(P0,8), pw1[1]=PKW(P0,10), pw1); \
    VRD(5); SBAR(); GAPA(C1=__builtin_amdgcn_mfma_f32_32x32x16_bf16(kf[3],qr[1],C1,0,0,0),   P0[14],P0[15],P1[0],P1[1],   pw1[2]=PKW(P0,12),pw1[3]=PKW(P0,14), pw1); \
    VRD(2); SBAR(); GAPA(C0=__builtin_amdgcn_mfma_f32_32x32x16_bf16(kf[4],qr[2],C0,0,0,0),   P1[2],P1[3],P1[4],P1[5],     pw2[0]=PKW(P1,0), pw2[1]=PKW(P1,2), pw2); \
    VRD(6); SBAR(); GAPA(C1=__builtin_amdgcn_mfma_f32_32x32x16_bf16(kf[5],qr[2],C1,0,0,0),   P1[6],P1[7],P1[8],P1[9],     pw2[2]=PKW(P1,4), pw2[3]=PKW(P1,6), pw2); \
    VRD(3); SBAR(); GAPA(C0=__builtin_amdgcn_mfma_f32_32x32x16_bf16(kf[6],qr[3],C0,0,0,0),   P1[10],P1[11],P1[12],P1[13], pw3[0]=PKW(P1,8), pw3[1]=PKW(P1,10), pw3); \
    VRD(7); SBAR(); GAPA(C1=__builtin_amdgcn_mfma_f32_32x32x16_bf16(kf[7],qr[3],C1,0,0,0),   P1[14],P1[15],0.f,0.f,       pw3[2]=PKW(P1,12),pw3[3]=PKW(P1,14), pw3); \
    l_reg+=sacc; \
    if(GK){DMA_K((t)+3,sl_cur);} if(GV){DMA_V((t)+1,sl_next);} \
    CMASK(C0,C1,t); \
    { float a=MX3(C0[0],C0[1],C1[0]),b=MX3(C0[2],C0[3],C1[1]); a=MX3(a,C1[2],C1[3]); \
      _Pragma("unroll") for(int r=4;r<16;r+=4){a=MX3(a,C0[r],C0[r+1]);b=MX3(b,C0[r+2],C0[r+3]);a=MX3(a,C1[r],C1[r+1]);b=MX3(b,C1[r+2],C1[r+3]);} \
      float rm=__builtin_fmaxf(a,b); { auto rr=__builtin_amdgcn_permlane32_swap(__float_as_uint(rm),__float_as_uint(rm),false,false); rm=__builtin_fmaxf(__uint_as_float(rr[0]),__uint_as_float(rr[1])); } \
      resc=false; \
      if(__builtin_expect(__any(rm>(float)THRL),0)){ const float dl=__builtin_fmaxf(rm,0.f); mhat+=dl; \
        _Pragma("unroll") for(int r=0;r<16;++r){C0[r]-=dl;C1[r]-=dl;} \
        _Pragma("unroll") for(int r=0;r<16;++r)negm[r]=-mhat; asm volatile("":"+v"(negm)); \
        const float f=__builtin_amdgcn_exp2f(-dl); l_reg*=f; if(hi==0)wsf[r32]=f; resc=true; } } \
    SBAR(); \
    GAPB(o[0]=__builtin_amdgcn_mfma_f32_32x32x16_bf16(PAF(0),VFR(0),o[0],0,0,0), C0,0); \
    GAPB(o[1]=__builtin_amdgcn_mfma_f32_32x32x16_bf16(PAF(0),VFR(4),o[1],0,0,0), C0,4); \
    KRD(GL,0); GAPB(o[0]=__builtin_amdgcn_mfma_f32_32x32x16_bf16(PAF(1),VFR(1),o[0],0,0,0), C0,8); \
    KRD(GL,1); GAPB(o[1]=__builtin_amdgcn_mfma_f32_32x32x16_bf16(PAF(1),VFR(5),o[1],0,0,0), C0,12); \
    KRD(GL,2); GAPB(o[0]=__builtin_amdgcn_mfma_f32_32x32x16_bf16(PAF(2),VFR(2),o[0],0,0,0), C1,0); \
    KRD(GL,3); GAPB(o[1]=__builtin_amdgcn_mfma_f32_32x32x16_bf16(PAF(2),VFR(6),o[1],0,0,0), C1,4); \
    GAPB(o[0]=__builtin_amdgcn_mfma_f32_32x32x16_bf16(PAF(3),VFR(3),o[0],0,0,0), C1,8); \
    GAPB(o[1]=__builtin_amdgcn_mfma_f32_32x32x16_bf16(PAF(3),VFR(7),o[1],0,0,0), C1,12); \
    }while(0)
  int t=1;
  for(;t+5<NT;t+=2){
    STEP(pB0,pB1,pA0,pA1,t,true,true,true);     WAIT_BAR(2); RESC(); ROT();
    STEP(pA0,pA1,pB0,pB1,t+1,true,true,true);   WAIT_BAR(2); RESC(); ROT();
  }
  #define ENDW(tt) do{ if((tt)+3<NT){WAIT_BAR(2);} else if((tt)+2<NT){WAIT_BAR(1);} else {WAIT_BAR(0);} }while(0)
  for(;t+1<NT;t+=2){
    STEP(pB0,pB1,pA0,pA1,t,(t+3<NT),(t+1<NT),(t+1<NT));       ENDW(t);   RESC(); ROT();
    STEP(pA0,pA1,pB0,pB1,t+1,(t+4<NT),(t+2<NT),(t+2<NT));     ENDW(t+1); RESC(); ROT();
  }
  STEP(pB0,pB1,pA0,pA1,NT-1,false,false,false); RESC();
  { float sacc=pB0[0]+pB0[1]; _Pragma("unroll") for(int r=2;r<16;++r)sacc+=pB0[r]; _Pragma("unroll") for(int r=0;r<16;++r)sacc+=pB1[r]; l_reg+=sacc;
    pw0=(u32x4){PKW(pB0,0),PKW(pB0,2),PKW(pB0,4),PKW(pB0,6)};pw1=(u32x4){PKW(pB0,8),PKW(pB0,10),PKW(pB0,12),PKW(pB0,14)};pw2=(u32x4){PKW(pB1,0),PKW(pB1,2),PKW(pB1,4),PKW(pB1,6)};pw3=(u32x4){PKW(pB1,8),PKW(pB1,10),PKW(pB1,12),PKW(pB1,14)};
    SBAR(); pv(o,vb0+sl_cur,PAF(0),PAF(1),PAF(2),PAF(3)); }
  #undef PKW
  #undef PAF
  #undef VFR
  #undef PIN
  #undef MX3
  #undef GAPA
  #undef GAPB
  #undef EX
  #undef VRD
  #undef KRD
  #undef STEP
  #undef ENDW
  {auto rr=__builtin_amdgcn_permlane32_swap(__float_as_uint(l_reg),__float_as_uint(l_reg),false,false);l_reg=__uint_as_float(rr[0])+__uint_as_float(rr[1]);}
  l_reg+=__builtin_amdgcn_exp2f(sink_l2-mhat);
  if(hi==0)wsf[32+r32]=l_reg;asm volatile("s_waitcnt lgkmcnt(0)":::"memory");
  float rli[16];
  #pragma unroll
  for(int r=0;r<16;++r)rli[r]=__builtin_amdgcn_rcpf(wsf[32+crow(r,hi)]);
  bf16*Ow=Ow0+(long)wid*QBLK*op;
  { bf16*stg=(bf16*)(shm+LDS_OST)+wid*2048;
    #pragma unroll
    for(int r=0;r<16;++r){const int orow=crow(r,hi);
      #pragma unroll
      for(int d0=0;d0<2;++d0)stg[orow*64+d0*32+r32]=__float2bfloat16(o[d0][r]*rli[r]);}
    asm volatile("s_waitcnt lgkmcnt(0)":::"memory");
    #pragma unroll
    for(int i=0;i<4;++i){const int row=i*8+(lane>>3),ch=lane&7; const u32x4 v=*(const u32x4*)(stg+row*64+ch*8); ATTN_STORE16(Ow+(long)row*op+ch*8,v);} }
  asm volatile("s_waitcnt lgkmcnt(0)\n\ts_barrier":::"memory");
  #undef DMA_K
  #undef TROW
  #undef DMA_V
  #undef CMASK
  #undef START
  #undef RESC
  #undef ROT
}
constexpr int ATTN_LDS_BYTES=LDS_BYTES;
#undef SBAR
#undef WAIT_BAR
}
namespace cg = cooperative_groups;
using namespace cfg;
typedef unsigned short bf16;
#define LAS __attribute__((address_space(3)))
typedef float f32x4 __attribute__((ext_vector_type(4)));
typedef unsigned v4u __attribute__((ext_vector_type(4)));
typedef unsigned v2u __attribute__((ext_vector_type(2)));
constexpr int NWAVES = 8;
constexpr int RING_BYTES = 131072, LDSCTL_OFF = RING_BYTES, MISC_OFF = LDSCTL_OFF + 320, LDS_BYTES = 147456;
constexpr int CW_BAR = 1024;

__host__ __device__ constexpr size_t al256(size_t x) { return (x + 255) & ~(size_t)255; }
constexpr size_t WS_CTL = 0, CTL_BYTES = 65536;
constexpr size_t WS_MOD = WS_CTL + CTL_BYTES;
constexpr size_t WS_ROPE = WS_MOD + al256((size_t)2 * 3 * NMOD * 4);
constexpr size_t WS_XC = WS_ROPE + al256(128 * 32 * 4);
constexpr size_t WS_W1T = WS_XC + al256((size_t)NCTX * D * 4);
constexpr size_t W1T_ONE = (size_t)2 * DFF * D * 2;
constexpr size_t WS_W2T = WS_W1T + 4 * W1T_ONE;
constexpr size_t W2T_ONE = (size_t)D * DFF * 2;
constexpr size_t WS_WINAB = WS_W2T + 4 * W2T_ONE;
constexpr size_t WS_WINW = WS_WINAB + (size_t)1280 * D * 2;
constexpr size_t WS_WOUT = WS_WINW + (size_t)1536 * D * 2;
constexpr size_t WS_GLUT = WS_WOUT + (size_t)2 * D * D * 2;
constexpr size_t WS_FS = WS_GLUT + (size_t)1024 * 512 * 2;
constexpr size_t WS_OUTM = WS_FS + (size_t)32 * 256 * 512 * 2;
constexpr size_t WS_HN = WS_OUTM + (size_t)32 * 512 * S5K * 2;
constexpr size_t WS_REG = WS_HN + (size_t)MALL * D * 2;
constexpr size_t R_ACT = 0;
constexpr size_t R_CAT = 0;
constexpr size_t R_QB = R_CAT + (size_t)MALL * D * 2;
constexpr size_t KV_ROWS_PAD = (size_t)BATCH * KVROWS + 64;
constexpr size_t R0_KB = R_QB + (size_t)MALL * 512 * 2, R0_VB = R0_KB + KV_ROWS_PAD * 128 * 2;
constexpr size_t R0_UA = R0_VB + KV_ROWS_PAD * 128 * 2;
constexpr size_t R0_SS = R0_UA + (size_t)32 * NCH_PAD * S5K * 2;
constexpr size_t R0_G5 = R0_SS + (size_t)32 * NCH_PAD * 256 * 4;
constexpr size_t R0_END = R0_G5 + (size_t)MALL * 512 * 2;
constexpr size_t R1_KB = R_QB + (size_t)NLAT * 1024 * 2, R1_VB = R1_KB + KV_ROWS_PAD * 256 * 2, R1_END = R1_VB + KV_ROWS_PAD * 256 * 2;
constexpr size_t R_ACT_END = (size_t)MALL * DFF * 2;
constexpr size_t REG_BYTES = R0_END > R_ACT_END ? (R0_END > R1_END ? R0_END : R1_END) : (R_ACT_END > R1_END ? R_ACT_END : R1_END);
constexpr size_t WS_END = WS_REG + REG_BYTES;
static_assert(WS_END < (size_t)304 * 1000 * 1000, "workspace map must fit under the sum of the inputs (~306 MB)");

enum Op { OP_PROLOGUE = 0, OP_NORM, OP_FFNA, OP_FFNB, OP_INAB, OP_S5STATE, OP_S5SCAN, OP_S5OUT, OP_GLU, OP_ATTN0, OP_INWIN, OP_ATTN1, OP_WOUT };
struct Args { const float* in[24]; float* out; unsigned char* ws; int k_lo, k_hi; };

struct Frame {
    LAS unsigned char* lds; int tid, lane, wave, vcu, G;
    float* out; unsigned char* ws;
};
#define FIN(i) (A.in[i])
#define XB_TMO      128
#define XB_XCNT(j)  (256  + 64 * (j))
#define XB_XSUB(j)  (1280 + 64 * (j))
#define XB_XGEN(j)  (2304 + 64 * (j))
#define XB_TOP      3328
#define XB_TOPGEN   3392
#define XCD_BAR_WORDS 3456
#define XB_SPIN_CAP (1u << 18)

__device__ __forceinline__ unsigned xb_ld(unsigned* p)              { return __hip_atomic_load(p, __ATOMIC_RELAXED, __HIP_MEMORY_SCOPE_AGENT); }
__device__ __forceinline__ unsigned xb_add(unsigned* p, unsigned v) { return __hip_atomic_fetch_add(p, v, __ATOMIC_RELAXED, __HIP_MEMORY_SCOPE_AGENT); }
__device__ __forceinline__ unsigned xb_xcc_id() { return (unsigned)__builtin_amdgcn_s_getreg((3 << 11) | 20) & 0xFu; }
#define XB_SPIN(cond, bar) do { unsigned _sp = 0; while (cond) { __builtin_amdgcn_s_sleep(1); \
    if ((++_sp & 255u) == 0u) { if (xb_ld(&(bar)[XB_TMO])) break; if (_sp > XB_SPIN_CAP) { atomicAdd(&(bar)[XB_TMO], 1u); break; } } } } while (0)

struct XcdBarrier {
    unsigned* bar; unsigned x;
    volatile LAS unsigned* st;
};

__device__ __forceinline__ XcdBarrier xcd_barrier_post(unsigned* bar, volatile LAS unsigned* st) {
    XcdBarrier b; b.bar = bar; b.x = xb_xcc_id(); b.st = st;
    if (threadIdx.x == 0) (void)xb_add(&bar[XB_XCNT(b.x)], 1u);
    return b;
}
__device__ __forceinline__ void xcd_barrier_complete(unsigned* bar, unsigned x, unsigned& nloc, unsigned& nx) {
    const unsigned G = gridDim.x * gridDim.y * gridDim.z;
    unsigned sum, cnt, mine, sp = 0u;
    for (;;) {
        sum = 0u; cnt = 0u; mine = 0u;
#pragma unroll
        for (unsigned j = 0; j < 16; ++j) { const unsigned c = xb_ld(&bar[XB_XCNT(j)]); sum += c; cnt += (c > 0u) ? 1u : 0u; mine = (j == x) ? c : mine; }
        if (sum == G) break;
        __builtin_amdgcn_s_sleep(1);
        if ((++sp & 255u) == 0u) { if (xb_ld(&bar[XB_TMO])) break; if (sp > XB_SPIN_CAP) { atomicAdd(&bar[XB_TMO], 1u); break; } }
    }
    nloc = mine > 0u ? mine : 1u; nx = cnt > 0u ? cnt : 1u;
}

__device__ __forceinline__ void xcd_barrier(const XcdBarrier& b) {
    asm volatile("s_waitcnt vmcnt(0)" ::: "memory");
    __syncthreads();
    if (threadIdx.x == 0) {
        unsigned* bar = b.bar;
        __builtin_amdgcn_s_waitcnt(0);
        unsigned nloc = b.st[0], nx = b.st[1];
        if (nloc == 0u) { xcd_barrier_complete(bar, b.x, nloc, nx); b.st[0] = nloc; b.st[1] = nx; }
        const unsigned old = xb_add(&bar[XB_XSUB(b.x)], 1u);
        const unsigned gen = old / nloc;
        if (old + 1u == (gen + 1u) * nloc) {
            __builtin_amdgcn_fence(__ATOMIC_RELEASE, "agent");
            asm volatile("s_waitcnt vmcnt(0)" ::: "memory");
            const unsigned og = xb_add(&bar[XB_TOP], 1u);
            const unsigned tg = og / nx;
            if (og + 1u == (tg + 1u) * nx) xb_add(&bar[XB_TOPGEN], 1u);
            else XB_SPIN(xb_ld(&bar[XB_TOPGEN]) == tg, bar);
            __builtin_amdgcn_fence(__ATOMIC_ACQUIRE, "agent");
            xb_add(&bar[XB_XGEN(b.x)], 1u);
            asm volatile("s_waitcnt vmcnt(0)" ::: "memory");
        } else {
            XB_SPIN(xb_ld(&bar[XB_XGEN(b.x)]) == gen, bar);
            __builtin_amdgcn_fence(__ATOMIC_ACQUIRE, "agent");
            asm volatile("s_waitcnt vmcnt(0)" ::: "memory");
        }
    }
    __syncthreads();
}

__device__ __forceinline__ float wave_sum(float v) {
#pragma unroll
    for (int o = 1; o < 64; o <<= 1) v += __shfl_xor(v, o);
    return v;
}
__device__ __forceinline__ unsigned f2bf(float f) { unsigned u = __builtin_bit_cast(unsigned, f); return (u + 0x7fffu + ((u >> 16) & 1u)) >> 16; }
__device__ __forceinline__ unsigned pk2(float lo, float hi) { return f2bf(lo) | (f2bf(hi) << 16); }
__device__ __forceinline__ float silu_f(float x) { return x / (1.f + __expf(-x)); }

__device__ __forceinline__ void transpose_item(const float* W, int ldw, int col0, int K, bf16* WT, int n0, int kb, LAS float* scr, int lane) {
    const int k0 = 64 * kb;
#pragma unroll 8
    for (int i = 0; i < 32; ++i) { const int kk = 2 * i + (lane >> 5); scr[kk * 33 + (lane & 31)] = W[(size_t)(k0 + kk) * ldw + col0 + (lane & 31)]; }
    asm volatile("s_waitcnt lgkmcnt(0)" ::: "memory");
    const int c = lane & 7;
#pragma unroll
    for (int j = 0; j < 4; ++j) { const int n = (lane >> 3) + 8 * j; const LAS float* s = scr + (8 * c) * 33 + n;
        v4u o; o.x = pk2(s[0 * 33], s[1 * 33]); o.y = pk2(s[2 * 33], s[3 * 33]); o.z = pk2(s[4 * 33], s[5 * 33]); o.w = pk2(s[6 * 33], s[7 * 33]);
        *(v4u*)(WT + (size_t)(n0 + n) * K + k0 + 8 * c) = o; }
    asm volatile("s_waitcnt lgkmcnt(0)" ::: "memory");
}
__device__ __forceinline__ int headcol(int p) { const int bj = p >> 7, k = (p & 127) >> 5; return k * 64 + 32 * bj; }

__device__ __forceinline__ void prologue_transposes(Frame& F, const Args& A) {
    LAS float* scr = (LAS float*)(F.lds + F.wave * 16384);
    const int gw = F.vcu * NWAVES + F.wave, NGW = F.G * NWAVES;
    constexpr int I_W1 = (D / 64) * (2 * DFF / 32), I_W2 = (DFF / 64) * (D / 32), I_AB = 16 * (1280 / 32), I_WIN = 16 * (1536 / 32), I_WO = 16 * 32, I_GLU = 8 * (1024 / 32);
    constexpr int NIT = 4 * I_W1 + 4 * I_W2 + I_AB + I_WIN + 2 * I_WO + I_GLU;
    for (int it = gw; it < NIT; it += NGW) {
        int r = it;
        if (r < 4 * I_W1) { const int lw = r / I_W1; r %= I_W1; const int nb = r % (2 * DFF / 32), kb = r / (2 * DFF / 32); const int n0 = nb * 32, tile = n0 >> 8, p = n0 & 255;
            const float* W = (p < 128 ? FIN(7) : FIN(8)) + (size_t)lw * D * DFF;
            transpose_item(W, DFF, tile * 128 + (p & 127), D, (bf16*)(F.ws + WS_W1T + lw * W1T_ONE), n0, kb, scr, F.lane); continue; }
        r -= 4 * I_W1;
        if (r < 4 * I_W2) { const int lw = r / I_W2; r %= I_W2; const int nb = r % (D / 32), kb = r / (D / 32);
            transpose_item(FIN(9) + (size_t)lw * DFF * D, D, nb * 32, DFF, (bf16*)(F.ws + WS_W2T + lw * W2T_ONE), nb * 32, kb, scr, F.lane); continue; }
        r -= 4 * I_W2;
        if (r < I_AB) { const int nb = r % 40, kb = r / 40; const int n0 = nb * 32, tile = n0 >> 8; const int col0 = tile < 2 ? n0 : tile * 256 + headcol(n0 & 255);
            transpose_item(FIN(12), 1280, col0, D, (bf16*)(F.ws + WS_WINAB), n0, kb, scr, F.lane); continue; }
        r -= I_AB;
        if (r < I_WIN) { const int nb = r % 48, kb = r / 48; const int n0 = nb * 32, tile = n0 >> 8; const int col0 = tile * 256 + headcol(n0 & 255);
            transpose_item(FIN(22), 1536, col0, D, (bf16*)(F.ws + WS_WINW), n0, kb, scr, F.lane); continue; }
        r -= I_WIN;
        if (r < 2 * I_WO) { const int l = r / I_WO; r %= I_WO; const int nb = r % 32, kb = r / 32;
            transpose_item(FIN(10) + (size_t)l * D * D, D, nb * 32, D, (bf16*)(F.ws + WS_WOUT) + (size_t)l * D * D, nb * 32, kb, scr, F.lane); continue; }
        r -= 2 * I_WO;
        { const int nb = r % 32, kb = r / 32; const int n0 = nb * 32, tile = n0 >> 8, p = n0 & 255;
            transpose_item(FIN(21) + (p < 128 ? 0 : 512 * 512), 512, tile * 128 + (p & 127), 512, (bf16*)(F.ws + WS_GLUT), n0, kb, scr, F.lane); }
    }
}
__device__ __forceinline__ void prologue_mod(Frame& F, const Args& A) {
    LAS float* sl = (LAS float*)F.lds;
    LAS float* red = sl + 3 * 1024;
    for (int i = F.tid; i < 3 * 1024; i += NWAVES * 64) { const int s = i >> 10, k = i & 1023; const float v = s < 2 ? FIN(1)[s * D + k] : FIN(3)[k]; sl[i] = silu_f(v); }
    __syncthreads();
    float* MOD = (float*)(F.ws + WS_MOD);
    for (int it = F.vcu; it < 2 * (NMOD / 64); it += F.G) {
        const int l = it / (NMOD / 64), cb = it % (NMOD / 64); const int col = cb * 64 + F.lane;
        const float* W = FIN(4) + (size_t)l * D * NMOD + col;
        float a0 = 0.f, a1 = 0.f, a2 = 0.f; const int kbeg = F.wave * 128;
#pragma unroll 8
        for (int k = kbeg; k < kbeg + 128; ++k) { const float w = W[(size_t)k * NMOD]; a0 += sl[k] * w; a1 += sl[1024 + k] * w; a2 += sl[2048 + k] * w; }
        red[(F.wave * 3 + 0) * 64 + F.lane] = a0; red[(F.wave * 3 + 1) * 64 + F.lane] = a1; red[(F.wave * 3 + 2) * 64 + F.lane] = a2;
        __syncthreads();
        if (F.tid < 192) { const int s = F.tid >> 6, c = F.tid & 63; float v = 0.f;
#pragma unroll
            for (int w = 0; w < 8; ++w) v += red[(w * 3 + s) * 64 + c];
            MOD[((size_t)l * 3 + s) * NMOD + cb * 64 + c] = v + FIN(5)[l * NMOD + cb * 64 + c]; }
        __syncthreads();
    }
}
__device__ __forceinline__ void prologue_rope(Frame& F, const Args& A) {
    float* R = (float*)(F.ws + WS_ROPE);
    for (int i = F.tid; i < 128 * 16; i += NWAVES * 64) { const int pos = i >> 4, f = i & 15; const float inv = powf(10000.f, -(float)f / 16.f); const float ang = (float)pos * inv;
        R[pos * 32 + f] = cosf(ang); R[pos * 32 + 16 + f] = sinf(ang); }
}
__device__ __forceinline__ void prologue_s5_item(Frame& F, const Args& A, int g, int dir) {
    LAS float* PW = (LAS float*)F.lds;
    LAS float* BB = PW + 64 * 34 * 2;
    LAS float* CC = BB + 64 * 16 * 2;
    LAS float* BO = CC + 16 * 64 * 2;
    LAS float* CO = BO + 64 * 16 * 2;
    LAS float* KT = CO + 16 * 64 * 2;
    LAS float* KD = KT + 32 * 256;
    const float* lam_re = FIN(13); const float* lam_im = FIN(14); const float* b_re = FIN(15); const float* b_im = FIN(16); const float* c_re = FIN(17); const float* c_im = FIN(18); const float* lstep = FIN(19);
    __syncthreads();
    for (int dd = 0; dd < 2; ++dd) {
        const int gi = (dd == 0 ? dir : 1 - dir) * 32 + g; LAS float* Bd = dd == 0 ? BB : BO; LAS float* Cd = dd == 0 ? CC : CO;
        const float dt = expf(lstep[gi]);
        if (dd == 0) for (int i = F.tid; i < 64 * 33; i += NWAVES * 64) { const int p = i / 33, tau = i % 33;
            const float lre = fminf(lam_re[gi * 64 + p], -1e-4f), lim = lam_im[gi * 64 + p]; const float e = expf(lre * dt * (float)tau); float sn, cs; sincosf(lim * dt * (float)tau, &sn, &cs);
            PW[(p * 34 + tau) * 2] = e * cs; PW[(p * 34 + tau) * 2 + 1] = e * sn; }
        for (int i = F.tid; i < 64 * 16; i += NWAVES * 64) { const int p = i >> 4, j = i & 15;
            const float lre = fminf(lam_re[gi * 64 + p], -1e-4f), lim = lam_im[gi * 64 + p]; const float er = expf(lre * dt); float sn, cs; sincosf(lim * dt, &sn, &cs);
            const float nr = er * cs - 1.f, ni = er * sn, den = lre * lre + lim * lim; const float fr = (nr * lre + ni * lim) / den, fi = (ni * lre - nr * lim) / den;
            const float xr = b_re[((size_t)gi * 64 + p) * 16 + j], xi = b_im[((size_t)gi * 64 + p) * 16 + j];
            Bd[(p * 16 + j) * 2] = fr * xr - fi * xi; Bd[(p * 16 + j) * 2 + 1] = fr * xi + fi * xr;
            const int ii = j; Cd[(ii * 64 + p) * 2] = c_re[((size_t)gi * 16 + ii) * 64 + p]; Cd[(ii * 64 + p) * 2 + 1] = c_im[((size_t)gi * 16 + ii) * 64 + p]; }
    }
    __syncthreads();
    for (int e = F.tid; e < 32 * 256; e += NWAVES * 64) { const int tau = e >> 8, i = (e >> 4) & 15, j = e & 15; float acc = 0.f;
        for (int p = 0; p < 64; ++p) { const float cr = CC[(i * 64 + p) * 2], ci = CC[(i * 64 + p) * 2 + 1], wr_ = PW[(p * 34 + tau) * 2], wi = PW[(p * 34 + tau) * 2 + 1], br = BB[(p * 16 + j) * 2], bi = BB[(p * 16 + j) * 2 + 1];
            const float zr = cr * wr_ - ci * wi, zi = cr * wi + ci * wr_; acc += zr * br - zi * bi; }
        KT[e] = acc; }
    if (dir == 0) for (int e = F.tid; e < 256; e += NWAVES * 64) { const int i = e >> 4, j = e & 15; float acc = 0.f;
        for (int p = 0; p < 64; ++p) acc += CO[(i * 64 + p) * 2] * BO[(p * 16 + j) * 2] - CO[(i * 64 + p) * 2 + 1] * BO[(p * 16 + j) * 2 + 1];
        KD[e] = acc + (i == j ? FIN(20)[g * 16 + i] : 0.f); }
    __syncthreads();
    bf16* OUTM = (bf16*)(F.ws + WS_OUTM) + (size_t)g * 512 * S5K; bf16* FS = (bf16*)(F.ws + WS_FS) + (size_t)g * 256 * 512;
    for (int e = F.tid; e < 512 * 32 * 2; e += NWAVES * 64) { const int half = e & 1, s = (e >> 1) & 31, row = e >> 6, t = row >> 4, i = row & 15;
        if (dir == 0 ? (s > t) : (s <= t)) continue;
        const int tau = dir == 0 ? t - s : s - t; float v[8];
#pragma unroll
        for (int q = 0; q < 8; ++q) { v[q] = KT[tau * 256 + i * 16 + half * 8 + q]; if (dir == 0 && s == t) v[q] += KD[i * 16 + half * 8 + q]; }
        v4u o; o.x = pk2(v[0], v[1]); o.y = pk2(v[2], v[3]); o.z = pk2(v[4], v[5]); o.w = pk2(v[6], v[7]);
        *(v4u*)(OUTM + (size_t)row * S5K + s * 16 + half * 8) = o; }
    for (int e = F.tid; e < 512 * 16; e += NWAVES * 64) { const int pq = e & 15, row = e >> 4, t = row >> 4, i = row & 15; const int tau = dir == 0 ? t + 1 : S5T - t; float v[8];
#pragma unroll
        for (int q = 0; q < 4; ++q) { const int p = pq * 4 + q; const float cr = CC[(i * 64 + p) * 2], ci = CC[(i * 64 + p) * 2 + 1], wr_ = PW[(p * 34 + tau) * 2], wi = PW[(p * 34 + tau) * 2 + 1];
            v[2 * q] = cr * wr_ - ci * wi; v[2 * q + 1] = -(cr * wi + ci * wr_); }
        v4u o; o.x = pk2(v[0], v[1]); o.y = pk2(v[2], v[3]); o.z = pk2(v[4], v[5]); o.w = pk2(v[6], v[7]);
        *(v4u*)(OUTM + (size_t)row * S5K + 512 + dir * 128 + pq * 8) = o; }
    for (int e = F.tid; e < 128 * 32 * 2; e += NWAVES * 64) { const int half = e & 1, s = (e >> 1) & 31, rr = e >> 6, p = rr >> 1, ri = rr & 1; const int tau = dir == 0 ? S5T - 1 - s : s;
        const float wr_ = PW[(p * 34 + tau) * 2], wi = PW[(p * 34 + tau) * 2 + 1]; float v[8];
#pragma unroll
        for (int q = 0; q < 8; ++q) { const float br = BB[(p * 16 + half * 8 + q) * 2], bi = BB[(p * 16 + half * 8 + q) * 2 + 1]; v[q] = ri == 0 ? (wr_ * br - wi * bi) : (wr_ * bi + wi * br); }
        v4u o; o.x = pk2(v[0], v[1]); o.y = pk2(v[2], v[3]); o.z = pk2(v[4], v[5]); o.w = pk2(v[6], v[7]);
        *(v4u*)(FS + (size_t)(dir * 128 + rr) * 512 + s * 16 + half * 8) = o; }
    __syncthreads();
}

__device__ __forceinline__ void norm_phase(Frame& F, const float* xl, const float* xc, const float* gam, const float* MODl, int s, int nrows) {
    const int gw = F.vcu * NWAVES + F.wave, NGW = F.G * NWAVES; bf16* HN = (bf16*)(F.ws + WS_HN);
    for (int r = gw; r < nrows; r += NGW) {
        const float* x = r < NLAT ? xl + (size_t)r * D : xc + (size_t)(r - NLAT) * D;
        const float* m = MODl + (size_t)(r < SEQ ? 0 : (r < NLAT ? 1 : 2)) * NMOD;
        f32x4 v[4]; float ss = 0.f;
#pragma unroll
        for (int j = 0; j < 4; ++j) { v[j] = *(const f32x4*)(x + 4 * F.lane + 256 * j); ss += (v[j].x * v[j].x + v[j].y * v[j].y) + (v[j].z * v[j].z + v[j].w * v[j].w); }
        const float rs = rsqrtf(wave_sum(ss) * (1.f / D) + EPS);
#pragma unroll
        for (int j = 0; j < 4; ++j) { const int c = 4 * F.lane + 256 * j;
            const f32x4 gg = *(const f32x4*)(gam + c), sc = *(const f32x4*)(m + (3 * s + 1) * D + c), sh = *(const f32x4*)(m + (3 * s) * D + c);
            const f32x4 y = v[j] * rs * gg * (sc + 1.f) + sh;
            v2u o; o.x = pk2(y.x, y.y); o.y = pk2(y.z, y.w); *(v2u*)(HN + (size_t)r * D + c) = o; }
    }
}
__device__ __forceinline__ void s5_scan_phase(Frame& F, const Args& A) {
    if (F.wave != 0 || F.vcu >= 128) return;
    const int item = F.vcu, g = item & 31, dir = (item >> 5) & 1, b = item >> 6, p = F.lane; const int gi = dir * 32 + g;
    const float dt = expf(FIN(19)[gi]); const float lre = fminf(FIN(13)[gi * 64 + p], -1e-4f), lim = FIN(14)[gi * 64 + p];
    const float e = expf(lre * dt * (float)S5T); float sn, cs; sincosf(lim * dt * (float)S5T, &sn, &cs); const float lr = e * cs, li = e * sn;
    const float* SS = (const float*)(F.ws + WS_REG + R0_SS) + (size_t)g * NCH_PAD * 256 + dir * 128 + 2 * p;
    bf16* UA = (bf16*)(F.ws + WS_REG + R0_UA) + (size_t)g * NCH_PAD * S5K + 512 + dir * 128 + 2 * p;
    constexpr int NC = NCH_CTX / 2, NL = NCH_LAT / 2;
    float hr = 0.f, hi = 0.f;
    auto chunk_of = [&](int n) { return dir == 0 ? (n < NC ? NCH_LAT + b * NC + n : b * NL + (n - NC)) : (n < NC ? NCH_LAT + b * NC + (NC - 1 - n) : b * NL + (NL - 1 - (n - NC))); };
    for (int n0 = 0; n0 < NC + NL; n0 += 8) {
        float sr[8], si[8]; int ch[8];
#pragma unroll
        for (int q = 0; q < 8; ++q) { ch[q] = chunk_of(n0 + q); const float2 sv = *(const float2*)(SS + (size_t)ch[q] * 256); sr[q] = sv.x; si[q] = sv.y; }
#pragma unroll
        for (int q = 0; q < 8; ++q) { *(unsigned*)(UA + (size_t)ch[q] * S5K) = pk2(hr, hi);
            const float nr = lr * hr - li * hi + sr[q], ni = lr * hi + li * hr + si[q]; hr = nr; hi = ni; }
    }
}
__device__ __forceinline__ void attn0_phase(Frame& F) {
    using namespace attn_body;
    const __hip_bfloat16* QB = (const __hip_bfloat16*)(F.ws + WS_REG + R_QB); const __hip_bfloat16* KB = (const __hip_bfloat16*)(F.ws + WS_REG + R0_KB); const __hip_bfloat16* VB = (const __hip_bfloat16*)(F.ws + WS_REG + R0_VB);
    __hip_bfloat16* CAT = (__hip_bfloat16*)(F.ws + WS_REG + R_CAT); char* shm = (char*)F.lds;
    const int upc = 512 / F.G;
    for (int i = 0; i < upc; ++i) { const int uid = F.vcu * upc + i; const int bk = uid >> 7, w = uid & 127; const int b = bk >> 1, kvh = bk & 1, h = kvh * 4 + (w >> 5), qb = w & 31;
        const size_t qrow = (size_t)b * SEQ + qb * 256;
        attn_unit<0, 8>(QB + qrow * 512 + h * 64, 512, KB + (size_t)b * KVROWS * 128 + kvh * 64, VB + (size_t)b * KVROWS * 128 + kvh * 64, 128, CAT + qrow * 1024 + 512 + h * 64, 1024, KVROWS / 64, 0, 0, -INFINITY, shm, F.tid); }
    if ((F.vcu & 15) == 0 && (F.vcu >> 4) < 16) { const int idx = F.vcu >> 4, b = idx >> 3, h = idx & 7, kvh = h >> 2; const size_t qrow = (size_t)NLAT + b * CTX;
        attn_unit<0, 8>(QB + qrow * 512 + h * 64, 512, KB + (size_t)b * KVROWS * 128 + kvh * 64, VB + (size_t)b * KVROWS * 128 + kvh * 64, 128, CAT + qrow * 1024 + 512 + h * 64, 1024, CTX / 64, 0, 0, -INFINITY, shm, F.tid); }
}
__device__ __forceinline__ void attn1_phase(Frame& F, const Args& A) {
    using namespace attn_body;
    const __hip_bfloat16* QB = (const __hip_bfloat16*)(F.ws + WS_REG + R_QB); const __hip_bfloat16* KB = (const __hip_bfloat16*)(F.ws + WS_REG + R1_KB); const __hip_bfloat16* VB = (const __hip_bfloat16*)(F.ws + WS_REG + R1_VB);
    __hip_bfloat16* CAT = (__hip_bfloat16*)(F.ws + WS_REG + R_CAT); char* shm = (char*)F.lds;
    const int upc = 1024 / F.G;
    for (int i = 0; i < upc; ++i) { const int uid = F.vcu * upc + i; const int bk = uid >> 7, w = uid & 127; const int b = bk >> 2, kvh = bk & 3, h = kvh * 4 + (w >> 5), qb = w & 31;
        const int q0 = qb * 256; const int loc0 = q0 - 128 < 0 ? 0 : q0 - 128, loc1 = q0 + 384 > SEQ ? SEQ : q0 + 384; const int NT = 4 + (loc1 - loc0) / 64;
        const size_t qrow = (size_t)b * SEQ + q0;
        attn_unit<1, 8>(QB + qrow * 1024 + h * 64, 1024, KB + (size_t)b * KVROWS * 256 + kvh * 64, VB + (size_t)b * KVROWS * 256 + kvh * 64, 256, CAT + qrow * 1024 + h * 64, 1024, NT, CTX + loc0, loc0 - q0,
                        FIN(23)[h] * 1.4426950408889634f, shm, F.tid); }
}

__device__ __forceinline__ void run_op(Frame& F, const Args& A, int op, int p0, int p1, int p2) {
    using namespace pg8;
    float* MOD = (float*)(F.ws + WS_MOD); float* XC = (float*)(F.ws + WS_XC);
    bf16* HN = (bf16*)(F.ws + WS_HN); bf16* ACT = (bf16*)(F.ws + WS_REG + R_ACT); bf16* CAT = (bf16*)(F.ws + WS_REG + R_CAT);
    LAS unsigned char* ring = F.lds;
    const int bx = blockIdx.x;
    switch (op) {
    case OP_PROLOGUE: {
        prologue_mod(F, A);
        if (F.vcu >= F.G - 64) { const int item = F.G - 1 - F.vcu; prologue_s5_item(F, A, item & 31, item >> 5); }
        if (F.vcu == F.G / 2) prologue_rope(F, A);
        __syncthreads();
        prologue_transposes(F, A);
    } break;
    case OP_NORM: { const int l = p0, s = p1, nrows = p2 & 0xfffff, first = p2 >> 20;
        norm_phase(F, first ? FIN(0) : F.out, first ? FIN(2) : XC, FIN(6) + ((size_t)l * 3 + s) * D, MOD + (size_t)l * 3 * NMOD, s, nrows);
    } break;
    case OP_FFNA: { Gemm g{HN, (const bf16*)(F.ws + WS_W1T + p0 * W1T_ONE), D, D, D}; TileOrder S; S.init(p1, 2 * DFF / 256, F.G, bx, 0);
        EpiSwiglu E{ACT, DFF}; gemm_phase<EpiSwiglu, TileOrder, true>(ring, F.tid, g, S, E);
    } break;
    case OP_FFNB: { const int lw = p0, l = p1 >> 4, s = p1 & 15, nMt = p2 & 0xfffff, first = p2 >> 20;
        Gemm g{ACT, (const bf16*)(F.ws + WS_W2T + lw * W2T_ONE), DFF, DFF, DFF}; TileOrder S; S.init(nMt, D / 256, F.G, bx, 0);
        EpiResid E{first ? FIN(0) : F.out, first ? FIN(2) : XC, F.out, XC, MOD + (size_t)l * 3 * NMOD + (3 * s + 2) * D, 0.5f}; gemm_phase<EpiResid, TileOrder, true>(ring, F.tid, g, S, E);
    } break;
    case OP_WOUT: { const int l = p0, nMt = p1;
        Gemm g{CAT, (const bf16*)(F.ws + WS_WOUT) + (size_t)l * D * D, D, D, D}; TileOrder S; S.init(nMt, D / 256, F.G, bx, 0);
        EpiResid E{F.out, XC, F.out, XC, MOD + (size_t)l * 3 * NMOD + 5 * D, 1.0f}; gemm_phase<EpiResid, TileOrder, true>(ring, F.tid, g, S, E);
    } break;
    case OP_INAB: { Gemm g{HN, (const bf16*)(F.ws + WS_WINAB), D, D, D}; TileOrder S; S.init(MALL / 256, 5, F.G, bx, 0);
        EpiIn E{0, (bf16*)(F.ws + WS_REG + R0_UA), (bf16*)(F.ws + WS_REG + R_QB), 512, (bf16*)(F.ws + WS_REG + R0_KB), (bf16*)(F.ws + WS_REG + R0_VB), 128, FIN(11), (const float*)(F.ws + WS_ROPE)};
        gemm_phase<EpiIn, TileOrder, true>(ring, F.tid, g, S, E);
    } break;
    case OP_INWIN: { Gemm g{HN, (const bf16*)(F.ws + WS_WINW), D, D, D}; TileOrder S; S.init(MALL / 256, 6, F.G, bx, 0);
        EpiIn E{1, nullptr, (bf16*)(F.ws + WS_REG + R_QB), 1024, (bf16*)(F.ws + WS_REG + R1_KB), (bf16*)(F.ws + WS_REG + R1_VB), 256, FIN(11) + 2 * HD, (const float*)(F.ws + WS_ROPE)};
        gemm_phase<EpiIn, TileOrder, true>(ring, F.tid, g, S, E);
    } break;
    case OP_S5STATE: { Gemm g{(const bf16*)(F.ws + WS_REG + R0_UA), (const bf16*)(F.ws + WS_FS), S5K, 512, 512}; GroupOrder S{3, 1, 3, F.G, F.vcu};
        EpiS5State E{(float*)(F.ws + WS_REG + R0_SS)}; gemm_phase<EpiS5State, GroupOrder, true>(ring, F.tid, g, S, E);
    } break;
    case OP_S5SCAN: s5_scan_phase(F, A); break;
    case OP_S5OUT: { Gemm g{(const bf16*)(F.ws + WS_REG + R0_UA), (const bf16*)(F.ws + WS_OUTM), S5K, S5K, S5K}; GroupOrder S{3, 2, 3, F.G, F.vcu};
        EpiS5Out E{(bf16*)(F.ws + WS_REG + R0_G5)}; gemm_phase<EpiS5Out, GroupOrder, true>(ring, F.tid, g, S, E);
    } break;
    case OP_GLU: { Gemm g{(const bf16*)(F.ws + WS_REG + R0_G5), (const bf16*)(F.ws + WS_GLUT), 512, 512, 512}; TileOrder S; S.init(MALL / 256, 4, F.G, bx, 0);
        EpiGlu E{CAT, 1024}; gemm_phase<EpiGlu, TileOrder, true>(ring, F.tid, g, S, E);
    } break;
    case OP_ATTN0: attn0_phase(F); break;
    case OP_ATTN1: attn1_phase(F, A); break;
    default: break;
    }
}

#define T66 (MALL / 256)
#define T64 (NLAT / 256)
#define FIRST (1 << 20)
__device__ const int PROGRAM[][4] = {
    {OP_PROLOGUE, 0, 0, 0},
    {OP_NORM, 0, 0, MALL | FIRST}, {OP_FFNA, 0, T66, 0}, {OP_FFNB, 0, 0 * 16 + 0, T66 | FIRST},
    {OP_NORM, 0, 1, MALL}, {OP_INAB, 0, 0, 0},
    {OP_S5STATE, 0, 0, 0}, {OP_S5SCAN, 0, 0, 0}, {OP_S5OUT, 0, 0, 0}, {OP_GLU, 0, 0, 0}, {OP_ATTN0, 0, 0, 0},
    {OP_WOUT, 0, T66, 0},
    {OP_NORM, 0, 2, MALL}, {OP_FFNA, 1, T66, 0}, {OP_FFNB, 1, 0 * 16 + 2, T66},
    {OP_NORM, 1, 0, MALL}, {OP_FFNA, 2, T66, 0}, {OP_FFNB, 2, 1 * 16 + 0, T66},
    {OP_NORM, 1, 1, MALL}, {OP_INWIN, 0, 0, 0}, {OP_ATTN1, 0, 0, 0},
    {OP_WOUT, 1, T64, 0},
    {OP_NORM, 1, 2, NLAT}, {OP_FFNA, 3, T64, 0}, {OP_FFNB, 3, 1 * 16 + 2, T64},
};
constexpr int N_OPS = sizeof(PROGRAM) / sizeof(PROGRAM[0]);

__global__ void __launch_bounds__(NWAVES * 64, 2) mega(Args A) {
    extern __shared__ __attribute__((aligned(16))) unsigned char lds_raw[];
    for (int u = threadIdx.x; u < (LDS_BYTES - LDSCTL_OFF) / 4; u += NWAVES * 64) ((LAS unsigned*)((LAS unsigned char*)lds_raw + LDSCTL_OFF))[u] = 0u;
    __syncthreads();
    XcdBarrier bar = xcd_barrier_post((unsigned*)(A.ws + WS_CTL) + CW_BAR, (volatile LAS unsigned*)((LAS unsigned char*)lds_raw + MISC_OFF) + 8);
    for (int k = A.k_lo; k < A.k_hi; ++k) {
        int tid = threadIdx.x; asm volatile("" : "+v"(tid)); size_t zoff = 0; asm volatile("" : "+s"(zoff)); unsigned char* wsp = A.ws + zoff; float* outp = A.out + zoff;
        Frame F; F.lds = (LAS unsigned char*)lds_raw; F.tid = tid; F.lane = tid & 63; F.wave = __builtin_amdgcn_readfirstlane(tid >> 6);
        F.G = gridDim.x; { const int bx = blockIdx.x; F.vcu = (F.G % 8 == 0) ? (bx % 8) * (F.G / 8) + bx / 8 : bx; }
        F.out = outp; F.ws = wsp;
        const int op = __builtin_amdgcn_readfirstlane(PROGRAM[k][0]), p0 = __builtin_amdgcn_readfirstlane(PROGRAM[k][1]), p1 = __builtin_amdgcn_readfirstlane(PROGRAM[k][2]), p2 = __builtin_amdgcn_readfirstlane(PROGRAM[k][3]);
        run_op(F, A, op, p0, p1, p2);
        if (k + 1 < A.k_hi) {
            if (k == A.k_lo) { __syncthreads(); cg::this_grid().sync(); }
            else xcd_barrier(bar);
        }
    }
}

#ifndef MK_ONE_LAUNCH
#define MK_ONE_LAUNCH 0
#endif
extern "C" void kernel_launch(void* const* d_in, const int* in_sizes, int n_in, void* d_out, int out_size, void* d_ws, size_t ws_size, hipStream_t stream) {
    static int grid = 0;
    if (grid == 0) {
        int dev = 0, cus = 0;
        if (hipGetDevice(&dev) != hipSuccess || hipDeviceGetAttribute(&cus, hipDeviceAttributeMultiprocessorCount, dev) != hipSuccess) { grid = -1; return; }
        if (hipFuncSetAttribute((const void*)mega, hipFuncAttributeMaxDynamicSharedMemorySize, LDS_BYTES) != hipSuccess) { fprintf(stderr, "hipFuncSetAttribute failed\n"); grid = -1; return; }
        int per_cu = 0; (void)hipOccupancyMaxActiveBlocksPerMultiprocessor(&per_cu, (const void*)mega, NWAVES * 64, LDS_BYTES); (void)hipGetLastError();
        if (cus < 256 || per_cu < 1 || n_in != 24 || ws_size < WS_END) { fprintf(stderr, "kernel_launch: unsupported device/workspace (cus %d, per_cu %d, ws %zu need %zu)\n", cus, per_cu, ws_size, (size_t)WS_END); grid = -1; return; }
        grid = 256;
    }
    if (grid < 0) return;
    if (hipMemsetAsync((char*)d_ws + WS_CTL, 0, CTL_BYTES, stream) != hipSuccess) { fprintf(stderr, "memset failed\n"); return; }
    Args a{};
    for (int i = 0; i < 24; ++i) a.in[i] = (const float*)d_in[i];
    a.out = (float*)d_out; a.ws = (unsigned char*)d_ws;
#if MK_ONE_LAUNCH
    a.k_lo = 0; a.k_hi = N_OPS;
    void* kargs[] = {&a};
    hipError_t e = hipLaunchCooperativeKernel((const void*)mega, dim3(grid), dim3(NWAVES * 64), kargs, LDS_BYTES, stream);
    if (e != hipSuccess) fprintf(stderr, "cooperative launch failed: %s\n", hipGetErrorString(e));
#else
    for (int k = 0; k < N_OPS; ++k) { a.k_lo = k; a.k_hi = k + 1; hipLaunchKernelGGL(mega, dim3(grid), dim3(NWAVES * 64), LDS_BYTES, stream, a); }
#endif
}
```

```cpp
#include <hip/hip_runtime.h>
#include <hip/hip_bf16.h>
#include <hip/hip_cooperative_groups.h>
#include <cstdio>
#include <cstdint>
#include <cmath>
#define MK_ONE_LAUNCH 1
namespace pg8 {
#define PG8_LAS __attribute__((address_space(3)))
typedef unsigned short bf16_t;
typedef short bf16x8 __attribute__((ext_vector_type(8)));
typedef float f32x4 __attribute__((ext_vector_type(4)));
typedef float f32x2 __attribute__((ext_vector_type(2)));
typedef unsigned u32x4 __attribute__((ext_vector_type(4)));
constexpr int BM = 256, BK = 64, HALF = 128, HTB = HALF * BK * 2  , STAGE_BYTES = 8 * HTB, NXCD = 8, WGM = 8;

__host__ __device__ __forceinline__ int lds_byte(int r, int c) { const int st = (r >> 4) * 2 + (c >> 5), rr = r & 15, cc = c & 31, ob = rr * 64 + cc * 2; return st * 1024 + (ob ^ (((ob >> 9) & 1) << 5)); }
__host__ __device__ __forceinline__ void stage_rc(int b, int& R, int& C) { const int st = b / 1024, sb = b % 1024, swz = sb ^ (((sb >> 9) & 1) << 5); R = (st >> 1) * 16 + swz / 64; C = (st & 1) * 32 + (swz % 64) / 2; }
__host__ __device__ __forceinline__ int perm32(int rho) { const int n = rho >> 4, i = rho & 15; return 8 * (i >> 2) + 4 * n + (i & 3); }

struct Unit { int pm, pn, ks; };
struct Gemm { const bf16_t* A; const bf16_t* Bt; int lda, ldb, K; };

struct TileOrder {
    int nM, nN, nwg, G, c, pm0;
    __device__ void init(int nM_, int nN_, int G_, int c_, int pm0_) { nM = nM_; nN = nN_; nwg = nM * nN; G = G_; c = c_; pm0 = pm0_; }
    __device__ bool next(int i, Unit& u) const {
        const long L = (long)i * G + c; if (L >= nwg) return false;
        int wgid = (int)L; { const int q = nwg / NXCD, r = nwg % NXCD, xcd = wgid % NXCD, off = wgid / NXCD; wgid = (xcd < r ? xcd * (q + 1) : r * (q + 1) + (xcd - r) * q) + off; }
        const int nig = WGM * nN, gid = wgid / nig, fm = gid * WGM, gsz = (nM - fm) < WGM ? (nM - fm) : WGM;
        u.pm = pm0 + fm + ((wgid % nig) % gsz); u.pn = (wgid % nig) / gsz; u.ks = 0; return true;
    }
};
struct SplitOrder {
    int nsplit, G, c;
    __device__ bool next(int i, Unit& u) const {
        const int L = i * G + c; if (L >= 8 * nsplit) return false;
        const int tile = L / nsplit; u.pm = 64 + (tile >> 2); u.pn = tile & 3; u.ks = L % nsplit; return true;
    }
};
struct GroupOrder {
    int nMt, nNt, aStride, G, c;
    __device__ bool next(int i, Unit& u) const {
        const int L = i * G + c, per = nMt * nNt; if (L >= 32 * per) return false;
        const int g = L / per, r = L % per, mt = r / nNt, nt = r % nNt;
        u.pm = g * aStride + mt; u.pn = g * nNt + nt; u.ks = 0; return true;
    }
};

__device__ __forceinline__ float shx(float v, int lane, int m) { return __builtin_bit_cast(float, __builtin_amdgcn_ds_bpermute((lane ^ m) << 2, __builtin_bit_cast(int, v))); }
__device__ __forceinline__ unsigned cvt_pk_bf16(float lo, float hi) { unsigned r; asm volatile("v_cvt_pk_bf16_f32 %0, %1, %2" : "=v"(r) : "v"(lo), "v"(hi)); return r; }
__device__ __forceinline__ float fast_sigmoid(float x) { return __builtin_amdgcn_rcpf(1.f + __builtin_amdgcn_exp2f(-1.4426950408889634f * x)); }
__device__ __forceinline__ u32x4 pack8(const f32x4 a, const f32x4 b) { u32x4 w; w.x = cvt_pk_bf16(a[0], a[1]); w.y = cvt_pk_bf16(a[2], a[3]); w.z = cvt_pk_bf16(b[0], b[1]); w.w = cvt_pk_bf16(b[2], b[3]); return w; }

typedef f32x4 Acc[2][2][4][2];

template <class Epi, class Sched, bool ALIGN_EPI>
__device__ __forceinline__ void gemm_phase(PG8_LAS unsigned char* lds, const int tid, const Gemm g, const Sched& S, const Epi& E) {
    const int wid = __builtin_amdgcn_readfirstlane(tid >> 6), lane = tid & 63, wr = wid >> 2, wc = wid & 3, fr = lane & 15, fq = lane >> 4;
    const int K = g.K, nt = K / BK;
    unsigned voffA[2], voffB[2];
#pragma unroll
    for (int i = 0; i < 2; ++i) { int R, C; stage_rc(tid * 16 + i * 8192, R, C); const int Rb = Epi::PERM ? ((R & ~31) + perm32(R & 31)) : R;
        voffA[i] = (unsigned)(R * g.lda + C) * 2u; voffB[i] = (unsigned)(Rb * g.ldb + C) * 2u; }
    const size_t kstep = (size_t)(BK * 2);
    const size_t hstepA = (size_t)HALF * g.lda * 2, hstepB = (size_t)HALF * g.ldb * 2, tstepA = 2 * hstepA, tstepB = 2 * hstepB;
    const unsigned ldsw = (unsigned)wid * 1024u;
    const int aoff = lds_byte(wr * 64 + fr, fq * 8), boff = lds_byte(wc * 32 + fr, fq * 8);
#define PG8_SA(b, h) (((b) * 2 + (h)) * HTB)
#define PG8_SB(b, h) ((4 + (b) * 2 + (h)) * HTB)
#define PG8_STAGE(bufoff, gbase, voff) do { _Pragma("unroll") for (int _i = 0; _i < 2; ++_i) \
        __builtin_amdgcn_global_load_lds((const unsigned*)((const char*)(gbase) + (voff)[_i]), (PG8_LAS unsigned*)(lds + (bufoff) + ldsw + _i * 8192), 16, 0, 0); } while (0)
#define PG8_LDA(dst, b, h) do { _Pragma("unroll") for (int m = 0; m < 4; ++m) _Pragma("unroll") for (int k = 0; k < 2; ++k) dst[m][k] = *(const PG8_LAS bf16x8*)(lds + PG8_SA(b, h) + aoff + m * 2048 + k * 1024); } while (0)
#define PG8_LDB(dst, b, h) do { _Pragma("unroll") for (int n = 0; n < 2; ++n) _Pragma("unroll") for (int k = 0; k < 2; ++k) dst[n][k] = *(const PG8_LAS bf16x8*)(lds + PG8_SB(b, h) + boff + n * 2048 + k * 1024); } while (0)
#define PG8_MMA(ai, bj, At, Bt) do { __builtin_amdgcn_s_setprio(1); _Pragma("unroll") for (int m = 0; m < 4; ++m) _Pragma("unroll") for (int n = 0; n < 2; ++n) _Pragma("unroll") for (int k = 0; k < 2; ++k) \
        acc[ai][bj][m][n] = __builtin_amdgcn_mfma_f32_16x16x32_bf16(Bt[n][k], At[m][k], acc[ai][bj][m][n], 0, 0, 0); __builtin_amdgcn_s_setprio(0); } while (0)
#define PG8_WAIT_V(n) asm volatile("s_waitcnt vmcnt(" #n ")" ::: "memory")
#define PG8_WAIT_L(n) asm volatile("s_waitcnt lgkmcnt(" #n ")" ::: "memory")
#define PG8_BAR __builtin_amdgcn_s_barrier()
#define PG8_SCHED __builtin_amdgcn_sched_barrier(0)
    Unit cur, nxt; int ui = 0;
    if (!S.next(0, cur)) return;
    f32x4 acc[2][2][4][2];
#pragma unroll
    for (int a = 0; a < 2; ++a)
#pragma unroll
        for (int b = 0; b < 2; ++b)
#pragma unroll
            for (int m = 0; m < 4; ++m)
#pragma unroll
                for (int n = 0; n < 2; ++n) acc[a][b][m][n] = (f32x4){0.f, 0.f, 0.f, 0.f};
    bf16x8 At[4][2], B0[2][2], B1[2][2];
    const size_t ksb = (size_t)K * 2;
    const char* cA = (const char*)g.A + (size_t)cur.pm * tstepA + cur.ks * ksb; const char* cB = (const char*)g.Bt + (size_t)cur.pn * tstepB + cur.ks * ksb;
    PG8_STAGE(PG8_SB(0, 0), cB, voffB); PG8_STAGE(PG8_SB(0, 1), cB + hstepB, voffB); PG8_STAGE(PG8_SA(0, 0), cA, voffA); PG8_STAGE(PG8_SA(0, 1), cA + hstepA, voffA);
    if (wr == 1) PG8_BAR;
    PG8_WAIT_V(2); PG8_BAR;
    PG8_STAGE(PG8_SB(1, 0), cB + kstep, voffB); PG8_STAGE(PG8_SA(1, 0), cA + kstep, voffA); PG8_STAGE(PG8_SB(1, 1), cB + hstepB + kstep, voffB);
    PG8_WAIT_V(6); PG8_BAR;
    for (;;) {
        const bool has_next = S.next(ui + 1, nxt);
        const char* nA = has_next ? (const char*)g.A + (size_t)nxt.pm * tstepA + nxt.ks * ksb : cA; const char* nB = has_next ? (const char*)g.Bt + (size_t)nxt.pn * tstepB + nxt.ks * ksb : cB;
        for (int t = 0; t < nt; t += 2) {
            const bool last = (t == nt - 2);
            const char* a1 = cA + (size_t)(t + 1) * kstep;
            const char* a2 = last ? nA : cA + (size_t)(t + 2) * kstep; const char* b2 = last ? nB : cB + (size_t)(t + 2) * kstep;
            const char* a3 = a2 + kstep; const char* b3 = b2 + kstep;
            PG8_LDB(B0, 0, 0); PG8_LDB(B1, 0, 1); PG8_SCHED; PG8_LDA(At, 0, 0); PG8_STAGE(PG8_SA(1, 1), a1 + hstepA, voffA);
            PG8_WAIT_V(8); PG8_WAIT_L(0); PG8_BAR; PG8_MMA(0, 0, At, B0); PG8_MMA(0, 1, At, B1); PG8_BAR; PG8_SCHED;
            PG8_LDA(At, 0, 1); PG8_STAGE(PG8_SB(0, 0), b2, voffB); PG8_STAGE(PG8_SB(0, 1), b2 + hstepB, voffB); PG8_STAGE(PG8_SA(0, 0), a2, voffA);
            PG8_WAIT_V(8); PG8_WAIT_L(0); PG8_BAR; PG8_MMA(1, 0, At, B0); PG8_MMA(1, 1, At, B1); PG8_BAR; PG8_SCHED;
            PG8_LDB(B0, 1, 0); PG8_LDB(B1, 1, 1); PG8_SCHED; PG8_LDA(At, 1, 0); PG8_STAGE(PG8_SA(0, 1), a2 + hstepA, voffA);
            PG8_WAIT_V(8); PG8_WAIT_L(0); PG8_BAR; PG8_MMA(0, 0, At, B0); PG8_MMA(0, 1, At, B1); PG8_BAR; PG8_SCHED;
            PG8_LDA(At, 1, 1); PG8_STAGE(PG8_SB(1, 0), b3, voffB); PG8_STAGE(PG8_SB(1, 1), b3 + hstepB, voffB); PG8_STAGE(PG8_SA(1, 0), a3, voffA);
            PG8_WAIT_V(8); PG8_WAIT_L(0); PG8_BAR; PG8_MMA(1, 0, At, B0); PG8_MMA(1, 1, At, B1); PG8_BAR; PG8_SCHED;
        }
        if constexpr (ALIGN_EPI) { if (wr == 0) PG8_BAR; }
        E(acc, cur, wr, wc, fr, fq);
        if (!has_next) break;
#pragma unroll
        for (int a = 0; a < 2; ++a)
#pragma unroll
            for (int b = 0; b < 2; ++b)
#pragma unroll
                for (int m = 0; m < 4; ++m)
#pragma unroll
                    for (int n = 0; n < 2; ++n) acc[a][b][m][n] = (f32x4){0.f, 0.f, 0.f, 0.f};
        cur = nxt; cA = nA; cB = nB; ++ui;
        if constexpr (ALIGN_EPI) { if (wr == 1) PG8_BAR; }
    }
    PG8_WAIT_V(0);
    if constexpr (!ALIGN_EPI) { if (wr == 0) PG8_BAR; }
    PG8_BAR;
#undef PG8_SA
#undef PG8_SB
#undef PG8_STAGE
#undef PG8_LDA
#undef PG8_LDB
#undef PG8_MMA
#undef PG8_WAIT_V
#undef PG8_WAIT_L
#undef PG8_BAR
#undef PG8_SCHED
}
}
namespace cfg {
constexpr int D = 1024, BATCH = 2, SEQ = 8192, CTX = 256, HD = 64, DFF = 2816;
constexpr int NLAT = BATCH * SEQ, NCTX = BATCH * CTX, MALL = NLAT + NCTX;
constexpr int NMOD = 9 * D;
constexpr float EPS = 1e-6f;
constexpr int KVROWS = CTX + SEQ;
constexpr int S5T = 32;
constexpr int S5K = S5T * 16 + 256;
constexpr int NCH_LAT = NLAT / S5T, NCH_CTX = NCTX / S5T, NCH = NCH_LAT + NCH_CTX, NCH_PAD = 768;
constexpr float C2 = 0.125f * 1.4426950408889634f;
}

namespace pg8 {
using namespace cfg;
struct EpiSwiglu { static constexpr bool PERM = true; bf16_t* O; int ldo;
    __device__ __forceinline__ void operator()(const Acc& acc, const Unit& u, int wr, int wc, int fr, int fq) const {
        asm volatile("" : "+v"(fr), "+v"(fq));
        const int row0 = u.pm * BM + wr * 64 + fr, col0 = u.pn * 128 + wc * 32 + 8 * fq;
#pragma unroll
        for (int ai = 0; ai < 2; ++ai)
#pragma unroll
            for (int m = 0; m < 4; ++m) { f32x4 v[2];
#pragma unroll
                for (int n = 0; n < 2; ++n) { const f32x4 gg = acc[ai][0][m][n], uu = acc[ai][1][m][n];
#pragma unroll
                    for (int j = 0; j < 4; ++j) v[n][j] = gg[j] * fast_sigmoid(gg[j]) * uu[j]; }
                *(u32x4*)(O + (size_t)(row0 + ai * HALF + m * 16) * ldo + col0) = pack8(v[0], v[1]); }
    }
};
struct EpiGlu { static constexpr bool PERM = true; bf16_t* O; int ldo;
    __device__ __forceinline__ void operator()(const Acc& acc, const Unit& u, int wr, int wc, int fr, int fq) const {
        asm volatile("" : "+v"(fr), "+v"(fq));
        const int row0 = u.pm * BM + wr * 64 + fr, col0 = u.pn * 128 + wc * 32 + 8 * fq;
#pragma unroll
        for (int ai = 0; ai < 2; ++ai)
#pragma unroll
            for (int m = 0; m < 4; ++m) { f32x4 v[2];
#pragma unroll
                for (int n = 0; n < 2; ++n) { const f32x4 aa = acc[ai][0][m][n], bb = acc[ai][1][m][n];
#pragma unroll
                    for (int j = 0; j < 4; ++j) v[n][j] = aa[j] * fast_sigmoid(bb[j]); }
                *(u32x4*)(O + (size_t)(row0 + ai * HALF + m * 16) * ldo + col0) = pack8(v[0], v[1]); }
    }
};
struct EpiResid { static constexpr bool PERM = false; const float* baseL; const float* baseC; float* outL; float* outC; const float* gate; float coef;
    __device__ __forceinline__ void operator()(const Acc& acc, const Unit& u, int wr, int wc, int fr, int fq) const {
        asm volatile("" : "+v"(fr), "+v"(fq));
        const int src = u.pm < 32 ? 0 : (u.pm < 64 ? 1 : 2);
        const float* gt = gate + (size_t)src * NMOD;
        const float* base = u.pm < 64 ? baseL + (size_t)u.pm * BM * D : baseC + (size_t)(u.pm - 64) * BM * D;
        float* out = u.pm < 64 ? outL + (size_t)u.pm * BM * D : outC + (size_t)(u.pm - 64) * BM * D;
        const int col0 = u.pn * BM + wc * 32 + 4 * fq;
        f32x4 gv[2][2];
#pragma unroll
        for (int bj = 0; bj < 2; ++bj)
#pragma unroll
            for (int n = 0; n < 2; ++n) gv[bj][n] = *(const f32x4*)(gt + col0 + bj * HALF + n * 16) * coef;
#pragma unroll
        for (int ai = 0; ai < 2; ++ai)
#pragma unroll
            for (int m = 0; m < 4; ++m) { const size_t off = (size_t)(wr * 64 + fr + ai * HALF + m * 16) * D + col0;
#pragma unroll
                for (int bj = 0; bj < 2; ++bj)
#pragma unroll
                    for (int n = 0; n < 2; ++n) { const f32x4 b = *(const f32x4*)(base + off + bj * HALF + n * 16); *(f32x4*)(out + off + bj * HALF + n * 16) = b + gv[bj][n] * acc[ai][bj][m][n]; } }
    }
};
struct EpiSlab { static constexpr bool PERM = false; float* slab;
    __device__ __forceinline__ void operator()(const Acc& acc, const Unit& u, int wr, int wc, int fr, int fq) const {
        asm volatile("" : "+v"(fr), "+v"(fq));
        float* out = slab + ((size_t)u.ks * NCTX + (size_t)(u.pm - 64) * BM) * D; const int col0 = u.pn * BM + wc * 32 + 4 * fq;
#pragma unroll
        for (int ai = 0; ai < 2; ++ai)
#pragma unroll
            for (int m = 0; m < 4; ++m) { const size_t off = (size_t)(wr * 64 + fr + ai * HALF + m * 16) * D + col0;
#pragma unroll
                for (int bj = 0; bj < 2; ++bj)
#pragma unroll
                    for (int n = 0; n < 2; ++n) *(f32x4*)(out + off + bj * HALF + n * 16) = acc[ai][bj][m][n]; }
    }
};
struct EpiIn { static constexpr bool PERM = true;
    int mode;
    bf16_t* UA; bf16_t* QB; int qp; bf16_t* KB; bf16_t* VB; int kp; const float* qkg; const float* rope;
    __device__ __forceinline__ void operator()(const Acc& acc, const Unit& u, int wr, int wc, int fr, int fq) const {
        asm volatile("" : "+v"(fr), "+v"(fq));
        int role, head;
        if (mode == 0) { if (u.pn < 2) { role = 0; head = 0; } else if (u.pn < 4) { role = 1; head = 4 * (u.pn - 2) + wc; } else { role = (wc < 2) ? 2 : 3; head = wc & 1; } }
        else { if (u.pn < 4) { role = 1; head = 4 * u.pn + wc; } else if (u.pn == 4) { role = 2; head = wc; } else { role = 3; head = wc; } }
        const bool isctx = u.pm >= 64;
        if (role == 1 && isctx && mode == 1) return;
        const int rbase = u.pm * BM + wr * 64 + fr;
        if (role == 0) {
#pragma unroll
            for (int ai = 0; ai < 2; ++ai)
#pragma unroll
                for (int m = 0; m < 4; ++m) { const int R = rbase + ai * HALF + m * 16; const int ch = isctx ? NCH_LAT + ((R - NLAT) >> 5) : (R >> 5); const int s = R & 31;
#pragma unroll
                    for (int bj = 0; bj < 2; ++bj) { const int cu = u.pn * BM + bj * HALF + wc * 32 + 8 * fq; const int g = cu >> 4, j0 = cu & 15;
                        *(u32x4*)(UA + ((size_t)(g * NCH_PAD + ch) * S5K + s * 16 + j0)) = pack8(acc[ai][bj][m][0], acc[ai][bj][m][1]); } }
            return;
        }
        f32x4 glo[2], ghi[2];
        if (role != 3) { const float* gp = qkg + (role == 1 ? 0 : HD) + 8 * fq; glo[0] = *(const f32x4*)gp; glo[1] = *(const f32x4*)(gp + 4); ghi[0] = *(const f32x4*)(gp + 32); ghi[1] = *(const f32x4*)(gp + 36); }
        const float qs = (role == 1) ? C2 : 1.f;
#pragma unroll
        for (int ai = 0; ai < 2; ++ai)
#pragma unroll
            for (int m = 0; m < 4; ++m) { const int R = rbase + ai * HALF + m * 16;
                int b, t; if (isctx) { b = (R - NLAT) >> 8; t = (R - NLAT) & 255; } else { b = R >> 13; t = R & 8191; }
                f32x4 lo[2] = {acc[ai][0][m][0], acc[ai][0][m][1]}, hi[2] = {acc[ai][1][m][0], acc[ai][1][m][1]};
                if (role != 3) {
                    float ss = 0.f;
#pragma unroll
                    for (int n = 0; n < 2; ++n)
#pragma unroll
                        for (int j = 0; j < 4; ++j) ss += lo[n][j] * lo[n][j] + hi[n][j] * hi[n][j];
                    { const int ln = fq * 16 + fr; ss += shx(ss, ln, 16); ss += shx(ss, ln, 32); }
                    const float rs = rsqrtf(ss * (1.f / HD) + EPS) ;
#pragma unroll
                    for (int n = 0; n < 2; ++n) { lo[n] = lo[n] * rs * glo[n]; hi[n] = hi[n] * rs * ghi[n]; }
                    if (!isctx) {
                        const int pos = (fq < 2) ? (t >> 6) : (t & 63); const float* rp = rope + pos * 32 + 8 * (fq & 1);
#pragma unroll
                        for (int n = 0; n < 2; ++n) { const f32x4 cs = *(const f32x4*)(rp + 4 * n), sn = *(const f32x4*)(rp + 16 + 4 * n);
                            const f32x4 x1 = lo[n], x2 = hi[n]; lo[n] = x1 * cs - x2 * sn; hi[n] = x1 * sn + x2 * cs; }
                    }
#pragma unroll
                    for (int n = 0; n < 2; ++n) { lo[n] = lo[n] * qs; hi[n] = hi[n] * qs; }
                }
                bf16_t* dst;
                if (role == 1) dst = QB + (size_t)R * qp + head * HD + 8 * fq;
                else { const size_t kr = (size_t)b * KVROWS + (isctx ? t : CTX + t); dst = (role == 2 ? KB : VB) + kr * kp + head * HD + 8 * fq; }
                *(u32x4*)dst = pack8(lo[0], lo[1]); *(u32x4*)(dst + 32) = pack8(hi[0], hi[1]);
            }
    }
};
struct EpiS5State { static constexpr bool PERM = false; float* SS;
    __device__ __forceinline__ void operator()(const Acc& acc, const Unit& u, int wr, int wc, int fr, int fq) const {
        asm volatile("" : "+v"(fr), "+v"(fq));
        const int mt = u.pm % 3; const int col0 = wc * 32 + 4 * fq;
#pragma unroll
        for (int ai = 0; ai < 2; ++ai)
#pragma unroll
            for (int m = 0; m < 4; ++m) { const int rl = wr * 64 + fr + ai * HALF + m * 16; if (mt * BM + rl >= NCH) continue;
                float* rowp = SS + (size_t)(u.pm * BM + rl) * 256 + col0;
#pragma unroll
                for (int bj = 0; bj < 2; ++bj)
#pragma unroll
                    for (int n = 0; n < 2; ++n) *(f32x4*)(rowp + bj * HALF + n * 16) = acc[ai][bj][m][n]; }
    }
};
struct EpiS5Out { static constexpr bool PERM = true; bf16_t* G5;
    __device__ __forceinline__ void operator()(const Acc& acc, const Unit& u, int wr, int wc, int fr, int fq) const {
        asm volatile("" : "+v"(fr), "+v"(fq));
        const int g = u.pm / 3, mt = u.pm % 3, ntile = u.pn & 1;
#pragma unroll
        for (int ai = 0; ai < 2; ++ai)
#pragma unroll
            for (int m = 0; m < 4; ++m) { const int ch = mt * BM + wr * 64 + fr + ai * HALF + m * 16; if (ch >= NCH) continue;
                const int rowbase = ch < NCH_LAT ? ch * S5T : NLAT + (ch - NCH_LAT) * S5T;
#pragma unroll
                for (int bj = 0; bj < 2; ++bj) { const int nn = ntile * BM + bj * HALF + wc * 32 + 8 * fq; const int t = nn >> 4, i0 = nn & 15;
                    f32x4 v[2];
#pragma unroll
                    for (int n = 0; n < 2; ++n)
#pragma unroll
                        for (int j = 0; j < 4; ++j) { const float y = acc[ai][bj][m][n][j]; v[n][j] = y * fast_sigmoid(1.5957691216057308f * (y + 0.044715f * y * y * y)); }
                    *(u32x4*)(G5 + (size_t)(rowbase + t) * 512 + g * 16 + i0) = pack8(v[0], v[1]); } }
    }
};
}
namespace attn_body {
using bf16=__hip_bfloat16;
using bf16x8=__attribute__((ext_vector_type(8)))short;
using s16x4=__attribute__((ext_vector_type(4)))short;
using f32x16=__attribute__((ext_vector_type(16)))float;
using u32x4=__attribute__((ext_vector_type(4)))unsigned;
constexpr int D=64;
constexpr int NW=8,QBLK=32,QB=QBLK*NW,KVBLK=64;
__device__ __forceinline__ int crow(int r,int hi){return (r&3)+8*(r>>2)+4*hi;}
#define SBAR() __builtin_amdgcn_sched_barrier(0)
__device__ __forceinline__ void wmask(f32x16&p0,f32x16&p1,int kb0,int qrel,int hi){
  const float NEG=-INFINITY; const int kb=kb0+4*hi-qrel;
  #pragma unroll
  for(int r=0;r<16;++r){const int d=kb+(r&3)+8*(r>>2); if(d>128||d<-128)p0[r]=NEG; if(d+32>128||d+32<-128)p1[r]=NEG;}
}
constexpr int NSLOT=3, SLOTB=8192;
constexpr int LDS_K=0, LDS_V=NSLOT*SLOTB, LDS_WS=2*NSLOT*SLOTB, LDS_OST=LDS_WS+NW*64*4, LDS_BYTES=LDS_OST+NW*4096;
__device__ __forceinline__ void glds16(const void*gsrc,unsigned lds_dst){unsigned keep;
  asm volatile("s_mov_b32 %0, m0\n\ts_mov_b32 m0, %2\n\ts_nop 0\n\tglobal_load_lds_dwordx4 %1, off\n\ts_mov_b32 m0, %0":"=&s"(keep):"v"(gsrc),"s"(lds_dst):"memory");}
__device__ __forceinline__ float max3f(float a,float b,float c){float r;asm("v_max3_f32 %0, %1, %2, %3":"=v"(r):"v"(a),"v"(b),"v"(c));return r;}
__device__ __forceinline__ float max2f(float a,float b){float r;asm("v_max_f32_e32 %0, %1, %2":"=v"(r):"v"(a),"v"(b));return r;}
__device__ __forceinline__ float fadd_s(float a,float b){float r;asm("v_add_f32_e32 %0, %1, %2":"=v"(r):"v"(a),"v"(b));return r;}
__device__ __forceinline__ float fsub_s(float a,float b){float r;asm("v_sub_f32_e32 %0, %1, %2":"=v"(r):"v"(a),"v"(b));return r;}
typedef float f32x2_t __attribute__((ext_vector_type(2))); typedef __bf16 bf16x2_t __attribute__((ext_vector_type(2)));
__device__ __forceinline__ unsigned cvtpk_s(float lo,float hi){f32x2_t v={lo,hi};bf16x2_t b=__builtin_convertvector(v,bf16x2_t);return __builtin_bit_cast(unsigned,b);}
#define WAIT_BAR(N) asm volatile("s_waitcnt vmcnt(" #N ") lgkmcnt(0)\n\ts_barrier":::"memory")

__device__ __forceinline__ void qkt(f32x16&p0,f32x16&p1,const char*Kslot,const bf16x8*qr,const f32x16&negm,int r32,int hi){
  const char*kb=Kslot+hi*1024+r32*16;
  #pragma unroll
  for(int d0=0;d0<4;++d0){
    const bf16x8 b0=*reinterpret_cast<const bf16x8*>(kb+d0*2048);
    const bf16x8 b1=*reinterpret_cast<const bf16x8*>(kb+d0*2048+512);
    if(d0==0){p0=__builtin_amdgcn_mfma_f32_32x32x16_bf16(b0,qr[0],negm,0,0,0);p1=__builtin_amdgcn_mfma_f32_32x32x16_bf16(b1,qr[0],negm,0,0,0);}
    else{p0=__builtin_amdgcn_mfma_f32_32x32x16_bf16(b0,qr[d0],p0,0,0,0);p1=__builtin_amdgcn_mfma_f32_32x32x16_bf16(b1,qr[d0],p1,0,0,0);}}
}
typedef __attribute__((address_space(3))) const char* lds_cptr;
typedef short v4i16_t __attribute__((ext_vector_type(4)));
__device__ __forceinline__ void kload8(bf16x8*kf,lds_cptr kp){
  kf[0]=*(const __attribute__((address_space(3))) bf16x8*)(kp);      kf[1]=*(const __attribute__((address_space(3))) bf16x8*)(kp+512);
  kf[2]=*(const __attribute__((address_space(3))) bf16x8*)(kp+2048); kf[3]=*(const __attribute__((address_space(3))) bf16x8*)(kp+2560);
  kf[4]=*(const __attribute__((address_space(3))) bf16x8*)(kp+4096); kf[5]=*(const __attribute__((address_space(3))) bf16x8*)(kp+4608);
  kf[6]=*(const __attribute__((address_space(3))) bf16x8*)(kp+6144); kf[7]=*(const __attribute__((address_space(3))) bf16x8*)(kp+6656);
}
__device__ __forceinline__ void kload2(bf16x8*kf,lds_cptr kp,int j){ kf[2*j]=*(const __attribute__((address_space(3))) bf16x8*)(kp+j*2048); kf[2*j+1]=*(const __attribute__((address_space(3))) bf16x8*)(kp+j*2048+512); }
__device__ __forceinline__ s16x4 vtr(lds_cptr p){ return __builtin_bit_cast(s16x4,__builtin_amdgcn_ds_read_tr16_b64_v4i16((__attribute__((address_space(3))) v4i16_t*)p)); }
__device__ __forceinline__ float rowmax(const f32x16&p0,const f32x16&p1){
  float a=max3f(p0[0],p0[1],p1[0]),b=max3f(p0[2],p0[3],p1[1]);a=max3f(a,p1[2],p1[3]);
  #pragma unroll
  for(int r=4;r<16;r+=4){a=max3f(a,p0[r],p0[r+1]);b=max3f(b,p0[r+2],p0[r+3]);a=max3f(a,p1[r],p1[r+1]);b=max3f(b,p1[r+2],p1[r+3]);}
  const float m=max2f(a,b);
  auto rr=__builtin_amdgcn_permlane32_swap(__float_as_uint(m),__float_as_uint(m),false,false);
  return max2f(__uint_as_float(rr[0]),__uint_as_float(rr[1]));
}
__device__ __forceinline__ void pv(f32x16*o,int vb,bf16x8 pa0,bf16x8 pa1,bf16x8 pa2,bf16x8 pa3){
  #pragma unroll
  for(int d0=0;d0<2;++d0){s16x4 lo[4],hi[4];
    #pragma unroll
    for(int ks=0;ks<4;++ks){
      asm volatile("ds_read_b64_tr_b16 %0,%1 offset:%c2":"=&v"(lo[ks]):"v"(vb),"i"(d0*4096+ks*1024):"memory");
      asm volatile("ds_read_b64_tr_b16 %0,%1 offset:%c2":"=&v"(hi[ks]):"v"(vb),"i"(d0*4096+ks*1024+512):"memory");}
    asm volatile("s_waitcnt lgkmcnt(0)":::"memory");SBAR();
    #define PK(k) (bf16x8){lo[k][0],lo[k][1],lo[k][2],lo[k][3],hi[k][0],hi[k][1],hi[k][2],hi[k][3]}
    o[d0]=__builtin_amdgcn_mfma_f32_32x32x16_bf16(pa0,PK(0),o[d0],0,0,0);
    o[d0]=__builtin_amdgcn_mfma_f32_32x32x16_bf16(pa1,PK(1),o[d0],0,0,0);
    o[d0]=__builtin_amdgcn_mfma_f32_32x32x16_bf16(pa2,PK(2),o[d0],0,0,0);
    o[d0]=__builtin_amdgcn_mfma_f32_32x32x16_bf16(pa3,PK(3),o[d0],0,0,0);
    #undef PK
  }
}

#ifndef ATTN_STORE16
#define ATTN_STORE16(p,v) (*(u32x4*)(p)=(v))
#endif
template<int MODE,int THRL> __device__ __forceinline__ void attn_unit(const bf16*Qw0,int qp,const bf16*__restrict__ Kh,const bf16*__restrict__ Vh,int kp,bf16*Ow0,int op,int NT,int loc_row0,int krel0,float sink_l2,char*shm,const int tid){
  const int lane=tid&63,r32=lane&31,hi=lane>>5; const int wid=__builtin_amdgcn_readfirstlane(tid>>6);
  const bf16*Qw=Qw0+(long)wid*QBLK*qp;
  const unsigned lds0=(unsigned)(uintptr_t)shm;
  float*wsf=(float*)(shm+LDS_WS)+wid*64;
  const bf16*ksrc=Kh+(long)lane*kp+wid*8;
  const bf16*vsrc=Vh+(long)(16*(wid&3)+(lane>>2))*kp+(wid>>2)*32+(lane&3)*8;
  #define TROW(t) ((MODE==1&&(t)>=4)?(loc_row0+64*((t)-4)):(64*(t)))
  const unsigned kdst=lds0+LDS_K+wid*1024, vdst=lds0+LDS_V+wid*1024;
  #define DMA_K(t,slot) glds16(ksrc+(long)TROW(t)*kp,(unsigned)__builtin_amdgcn_readfirstlane(kdst+(slot)))
  #define DMA_V(t,slot) glds16(vsrc+(long)TROW(t)*kp,(unsigned)__builtin_amdgcn_readfirstlane(vdst+(slot)))
  const int vb0=(int)(lds0+LDS_V)+((lane>>4)&1)*32+(lane&3)*8+(4*hi+((lane&15)>>2))*64;
  const char*Kbase=shm+LDS_K; bf16x8 kf[8];
  const lds_cptr shm3=(lds_cptr)shm; const lds_cptr kp0=shm3+LDS_K+hi*1024+r32*16; const lds_cptr vp0=shm3+LDS_V+((lane>>4)&1)*32+(lane&3)*8+(4*hi+((lane&15)>>2))*64;
  DMA_K(0,0);DMA_V(0,0);DMA_K(1,SLOTB);
  bf16x8 qr[4];
  #pragma unroll
  for(int d0=0;d0<4;++d0)qr[d0]=*reinterpret_cast<const bf16x8*>(&Qw[(long)r32*qp+d0*16+hi*8]);
  float zf=0.f;asm volatile("":"+v"(zf));
  float mhat=0.f,l_reg=0.f;f32x16 o[2];f32x16 negm;
  #pragma unroll
  for(int r=0;r<16;++r){o[0][r]=zf;o[1][r]=zf;negm[r]=zf;}
  asm volatile("":"+v"(negm));
  const int qrel=wid*QBLK+r32;
  #define CMASK(P0,P1,t) do{ if(MODE==1&&(t)>=4) wmask(P0,P1,krel0+64*((t)-4),qrel,hi); }while(0)
  bool resc=false;
  #define START(P0,P1) do{ const float rm=rowmax(P0,P1); resc=false; \
    { const float dl=rm; mhat=fadd_s(mhat,dl); \
      _Pragma("unroll") for(int r=0;r<16;++r){P0[r]=fsub_s(P0[r],dl);P1[r]=fsub_s(P1[r],dl);} \
      _Pragma("unroll") for(int r=0;r<16;++r)negm[r]=-mhat; asm volatile("":"+v"(negm)); } \
    _Pragma("unroll") for(int r=0;r<16;++r)P0[r]=__builtin_amdgcn_exp2f(P0[r]); }while(0)
  #define RESC() do{ if(resc){ asm volatile("s_waitcnt lgkmcnt(0)":::"memory"); \
      _Pragma("unroll") for(int d_=0;d_<2;++d_) _Pragma("unroll") for(int r=0;r<16;++r)o[d_][r]*=wsf[crow(r,hi)]; } }while(0)
  f32x16 pA0,pA1,pB0,pB1;
  int sl_prev=0,sl_cur=0,sl_next=SLOTB;
  #define ROT() do{sl_prev=sl_cur;sl_cur=sl_next;sl_next=(sl_next==(NSLOT-1)*SLOTB)?0:sl_next+SLOTB;}while(0)
  DMA_K(2,2*SLOTB);
  WAIT_BAR(3);
  qkt(pA0,pA1,Kbase,qr,negm,r32,hi);asm volatile("s_nop 15\n\ts_nop 7":"+v"(pA0),"+v"(pA1));CMASK(pA0,pA1,0);
  START(pA0,pA1);
  _Pragma("unroll") for(int r=0;r<16;++r)pA1[r]=__builtin_amdgcn_exp2f(pA1[r]);
  WAIT_BAR(0);
  DMA_K(3,0);DMA_V(1,SLOTB);
  ROT();
  kload8(kf,kp0+sl_cur);
  WAIT_BAR(2);
  s16x4 vlo[8],vhi[8]; u32x4 pw0,pw1,pw2,pw3;
  #define PKW(P,B) cvtpk_s(P[B],P[B+1])
  #define PAF(k) __builtin_bit_cast(bf16x8,pw##k)
  #define VFR(i) (bf16x8){vlo[i][0],vlo[i][1],vlo[i][2],vlo[i][3],vhi[i][0],vhi[i][1],vhi[i][2],vhi[i][3]}
  #define PIN(x) asm volatile("":"+v"(x))
  #define MX3(a,b,c) __builtin_fmaxf(__builtin_fmaxf((a),(b)),(c))
  #define GAPA(MF,A0,A1,A2,A3,W0,W1,PW) do{ MF; sacc+=A0; sacc+=A1; sacc+=A2; sacc+=A3; PIN(sacc); W0; W1; PIN(PW); SBAR(); }while(0)
  #define EX(v) __builtin_amdgcn_exp2f(v)
  #define GAPB(MF,X,B) do{ MF; X[B]=EX(X[B]); X[B+1]=EX(X[B+1]); X[B+2]=EX(X[B+2]); X[B+3]=EX(X[B+3]); PIN(X); SBAR(); }while(0)
  #define VRD(i) do{ vlo[i]=vtr(vp_+(((i)>>2)*4096+((i)&3)*1024)); vhi[i]=vtr(vp_+(((i)>>2)*4096+((i)&3)*1024+512)); }while(0)
  #define KRD(G,j) do{ if(G){ kload2(kf,kp0+sl_next,j); SBAR(); } }while(0)
  #define STEP(C0,C1,P0,P1,t,GK,GV,GL) do{ SBAR(); \
    const lds_cptr vp_=vp0+sl_prev; \
    VRD(0); SBAR(); float sacc=(P0[0]+P0[1]); \
    GAPA(C0=__builtin_amdgcn_mfma_f32_32x32x16_bf16(kf[0],qr[0],negm,0,0,0), P0[2],P0[3],P0[4],P0[5],     pw0[0]=PKW(P0,0), pw0[1]=PKW(P0,2), pw0); \
    VRD(4); SBAR(); GAPA(C1=__builtin_amdgcn_mfma_f32_32x32x16_bf16(kf[1],qr[0],negm,0,0,0), P0[6],P0[7],P0[8],P0[9],     pw0[2]=PKW(P0,4), pw0[3]=PKW(P0,6), pw0); \
    VRD(1); SBAR(); GAPA(C0=__builtin_amdgcn_mfma_f32_32x32x16_bf16(kf[2],qr[1],C0,0,0,0),   P0[10],P0[11],P0[12],P0[13], pw1[0]=PKW(P0,8), pw1[1]=PKW(P0,10), pw1); \
    VRD(5); SBAR(); GAPA(C1=__builtin_amdgcn_mfma_f32_32x32x16_bf16(kf[3],qr[1],C1,0,0,0),   P0[14],P0[15],P1[0],P1[1],   pw1[2]=PKW(P0,12),pw1[3]=PKW(P0,14), pw1); \
    VRD(2); SBAR(); GAPA(C0=__builtin_amdgcn_mfma_f32_32x32x16_bf16(kf[4],qr[2],C0,0,0,0),   P1[2],P1[3],P1[4],P1[5],     pw2[0]=PKW(P1,0), pw2[1]=PKW(P1,2), pw2); \
    VRD(6); SBAR(); GAPA(C1=__builtin_amdgcn_mfma_f32_32x32x16_bf16(kf[5],qr[2],C1,0,0,0),   P1[6],P1[7],P1[8],P1[9],     pw2[2]=PKW(P1,4), pw2[3]=PKW(P1,6), pw2); \
    VRD(3); SBAR(); GAPA(C0=__builtin_amdgcn_mfma_f32_32x32x16_bf16(kf[6],qr[3],C0,0,0,0),   P1[10],P1[11],P1[12],P1[13], pw3[0]=PKW(P1,8), pw3[1]=PKW(P1,10), pw3); \
    VRD(7); SBAR(); GAPA(C1=__builtin_amdgcn_mfma_f32_32x32x16_bf16(kf[7],qr[3],C1,0,0,0),   P1[14],P1[15],0.f,0.f,       pw3[2]=PKW(P1,12),pw3[3]=PKW(P1,14), pw3); \
    l_reg+=sacc; \
    if(GK){DMA_K((t)+3,sl_cur);} if(GV){DMA_V((t)+1,sl_next);} \
    CMASK(C0,C1,t); \
    { float a=MX3(C0[0],C0[1],C1[0]),b=MX3(C0[2],C0[3],C1[1]); a=MX3(a,C1[2],C1[3]); \
      _Pragma("unroll") for(int r=4;r<16;r+=4){a=MX3(a,C0[r],C0[r+1]);b=MX3(b,C0[r+2],C0[r+3]);a=MX3(a,C1[r],C1[r+1]);b=MX3(b,C1[r+2],C1[r+3]);} \
      float rm=__builtin_fmaxf(a,b); { auto rr=__builtin_amdgcn_permlane32_swap(__float_as_uint(rm),__float_as_uint(rm),false,false); rm=__builtin_fmaxf(__uint_as_float(rr[0]),__uint_as_float(rr[1])); } \
      resc=false; \
      if(__builtin_expect(__any(rm>(float)THRL),0)){ const float dl=__builtin_fmaxf(rm,0.f); mhat+=dl; \
        _Pragma("unroll") for(int r=0;r<16;++r){C0[r]-=dl;C1[r]-=dl;} \
        _Pragma("unroll") for(int r=0;r<16;++r)negm[r]=-mhat; asm volatile("":"+v"(negm)); \
        const float f=__builtin_amdgcn_exp2f(-dl); l_reg*=f; if(hi==0)wsf[r32]=f; resc=true; } } \
    SBAR(); \
    GAPB(o[0]=__builtin_amdgcn_mfma_f32_32x32x16_bf16(PAF(0),VFR(0),o[0],0,0,0), C0,0); \
    GAPB(o[1]=__builtin_amdgcn_mfma_f32_32x32x16_bf16(PAF(0),VFR(4),o[1],0,0,0), C0,4); \
    KRD(GL,0); GAPB(o[0]=__builtin_amdgcn_mfma_f32_32x32x16_bf16(PAF(1),VFR(1),o[0],0,0,0), C0,8); \
    KRD(GL,1); GAPB(o[1]=__builtin_amdgcn_mfma_f32_32x32x16_bf16(PAF(1),VFR(5),o[1],0,0,0), C0,12); \
    KRD(GL,2); GAPB(o[0]=__builtin_amdgcn_mfma_f32_32x32x16_bf16(PAF(2),VFR(2),o[0],0,0,0), C1,0); \
    KRD(GL,3); GAPB(o[1]=__builtin_amdgcn_mfma_f32_32x32x16_bf16(PAF(2),VFR(6),o[1],0,0,0), C1,4); \
    GAPB(o[0]=__builtin_amdgcn_mfma_f32_32x32x16_bf16(PAF(3),VFR(3),o[0],0,0,0), C1,8); \
    GAPB(o[1]=__builtin_amdgcn_mfma_f32_32x32x16_bf16(PAF(3),VFR(7),o[1],0,0,0), C1,12); \
    }while(0)
  int t=1;
  for(;t+5<NT;t+=2){
    STEP(pB0,pB1,pA0,pA1,t,true,true,true);     WAIT_BAR(2); RESC(); ROT();
    STEP(pA0,pA1,pB0,pB1,t+1,true,true,true);   WAIT_BAR(2); RESC(); ROT();
  }
  #define ENDW(tt) do{ if((tt)+3<NT){WAIT_BAR(2);} else if((tt)+2<NT){WAIT_BAR(1);} else {WAIT_BAR(0);} }while(0)
  for(;t+1<NT;t+=2){
    STEP(pB0,pB1,pA0,pA1,t,(t+3<NT),(t+1<NT),(t+1<NT));       ENDW(t);   RESC(); ROT();
    STEP(pA0,pA1,pB0,pB1,t+1,(t+4<NT),(t+2<NT),(t+2<NT));     ENDW(t+1); RESC(); ROT();
  }
  STEP(pB0,pB1,pA0,pA1,NT-1,false,false,false); RESC();
  { float sacc=pB0[0]+pB0[1]; _Pragma("unroll") for(int r=2;r<16;++r)sacc+=pB0[r]; _Pragma("unroll") for(int r=0;r<16;++r)sacc+=pB1[r]; l_reg+=sacc;
    pw0=(u32x4){PKW(pB0,0),PKW(pB0,2),PKW(pB0,4),PKW(pB0,6)};pw1=(u32x4){PKW(pB0,8),PKW(pB0,10),PKW(pB0,12),PKW(pB0,14)};pw2=(u32x4){PKW(pB1,0),PKW(pB1,2),PKW(pB1,4),PKW(pB1,6)};pw3=(u32x4){PKW(pB1,8),PKW(pB1,10),PKW(pB1,12),PKW(pB1,14)};
    SBAR(); pv(o,vb0+sl_cur,PAF(0),PAF(1),PAF(2),PAF(3)); }
  #undef PKW
  #undef PAF
  #undef VFR
  #undef PIN
  #undef MX3
  #undef GAPA
  #undef GAPB
  #undef EX
  #undef VRD
  #undef KRD
  #undef STEP
  #undef ENDW
  {auto rr=__builtin_amdgcn_permlane32_swap(__float_as_uint(l_reg),__float_as_uint(l_reg),false,false);l_reg=__uint_as_float(rr[0])+__uint_as_float(rr[1]);}
  l_reg+=__builtin_amdgcn_exp2f(sink_l2-mhat);
  if(hi==0)wsf[32+r32]=l_reg;asm volatile("s_waitcnt lgkmcnt(0)":::"memory");
  float rli[16];
  #pragma unroll
  for(int r=0;r<16;++r)rli[r]=__builtin_amdgcn_rcpf(wsf[32+crow(r,hi)]);
  bf16*Ow=Ow0+(long)wid*QBLK*op;
  { bf16*stg=(bf16*)(shm+LDS_OST)+wid*2048;
    #pragma unroll
    for(int r=0;r<16;++r){const int orow=crow(r,hi);
      #pragma unroll
      for(int d0=0;d0<2;++d0)stg[orow*64+d0*32+r32]=__float2bfloat16(o[d0][r]*rli[r]);}
    asm volatile("s_waitcnt lgkmcnt(0)":::"memory");
    #pragma unroll
    for(int i=0;i<4;++i){const int row=i*8+(lane>>3),ch=lane&7; const u32x4 v=*(const u32x4*)(stg+row*64+ch*8); ATTN_STORE16(Ow+(long)row*op+ch*8,v);} }
  asm volatile("s_waitcnt lgkmcnt(0)\n\ts_barrier":::"memory");
  #undef DMA_K
  #undef TROW
  #undef DMA_V
  #undef CMASK
  #undef START
  #undef RESC
  #undef ROT
}
constexpr int ATTN_LDS_BYTES=LDS_BYTES;
#undef SBAR
#undef WAIT_BAR
}
namespace cg = cooperative_groups;
using namespace cfg;
typedef unsigned short bf16;
#define LAS __attribute__((address_space(3)))
typedef float f32x4 __attribute__((ext_vector_type(4)));
typedef unsigned v4u __attribute__((ext_vector_type(4)));
typedef unsigned v2u __attribute__((ext_vector_type(2)));
constexpr int NWAVES = 8;
constexpr int RING_BYTES = 131072, LDSCTL_OFF = RING_BYTES, MISC_OFF = LDSCTL_OFF + 320, LDS_BYTES = 147456;
constexpr int CW_BAR = 1024;

__host__ __device__ constexpr size_t al256(size_t x) { return (x + 255) & ~(size_t)255; }
constexpr size_t WS_CTL = 0, CTL_BYTES = 65536;
constexpr size_t WS_MOD = WS_CTL + CTL_BYTES;
constexpr size_t WS_ROPE = WS_MOD + al256((size_t)2 * 3 * NMOD * 4);
constexpr size_t WS_XC = WS_ROPE + al256(128 * 32 * 4);
constexpr size_t WS_W1T = WS_XC + al256((size_t)NCTX * D * 4);
constexpr size_t W1T_ONE = (size_t)2 * DFF * D * 2;
constexpr size_t WS_W2T = WS_W1T + 4 * W1T_ONE;
constexpr size_t W2T_ONE = (size_t)D * DFF * 2;
constexpr size_t WS_WINAB = WS_W2T + 4 * W2T_ONE;
constexpr size_t WS_WINW = WS_WINAB + (size_t)1280 * D * 2;
constexpr size_t WS_WOUT = WS_WINW + (size_t)1536 * D * 2;
constexpr size_t WS_GLUT = WS_WOUT + (size_t)2 * D * D * 2;
constexpr size_t WS_FS = WS_GLUT + (size_t)1024 * 512 * 2;
constexpr size_t WS_OUTM = WS_FS + (size_t)32 * 256 * 512 * 2;
constexpr size_t WS_HN = WS_OUTM + (size_t)32 * 512 * S5K * 2;
constexpr size_t WS_REG = WS_HN + (size_t)MALL * D * 2;
constexpr size_t R_ACT = 0;
constexpr size_t R_CAT = 0;
constexpr size_t R_QB = R_CAT + (size_t)MALL * D * 2;
constexpr size_t KV_ROWS_PAD = (size_t)BATCH * KVROWS + 64;
constexpr size_t R0_KB = R_QB + (size_t)MALL * 512 * 2, R0_VB = R0_KB + KV_ROWS_PAD * 128 * 2;
constexpr size_t R0_UA = R0_VB + KV_ROWS_PAD * 128 * 2;
constexpr size_t R0_SS = R0_UA + (size_t)32 * NCH_PAD * S5K * 2;
constexpr size_t R0_G5 = R0_SS + (size_t)32 * NCH_PAD * 256 * 4;
constexpr size_t R0_END = R0_G5 + (size_t)MALL * 512 * 2;
constexpr size_t R1_KB = R_QB + (size_t)NLAT * 1024 * 2, R1_VB = R1_KB + KV_ROWS_PAD * 256 * 2, R1_END = R1_VB + KV_ROWS_PAD * 256 * 2;
constexpr size_t R_ACT_END = (size_t)MALL * DFF * 2;
constexpr size_t R_SLAB = (size_t)100 << 20;

constexpr size_t REG_BYTES = R0_END > R_ACT_END ? (R0_END > R1_END ? R0_END : R1_END) : (R_ACT_END > R1_END ? R_ACT_END : R1_END);
constexpr size_t WS_END = WS_REG + REG_BYTES;
static_assert(R_SLAB >= R_ACT_END && R_SLAB + (size_t)11 * NCTX * D * 4 <= REG_BYTES, "slab placement");
static_assert(WS_END < (size_t)304 * 1000 * 1000, "workspace map must fit under the sum of the inputs (~306 MB)");

enum Op { OP_PROLOGUE = 0, OP_NORM, OP_FFNA, OP_FFNB, OP_INAB, OP_S5STATE, OP_S5SCAN, OP_S5OUT, OP_GLU, OP_ATTN0, OP_INWIN, OP_ATTN1, OP_WOUT };
struct Args { const float* in[24]; float* out; unsigned char* ws; int k_lo, k_hi; };

struct Frame {
    LAS unsigned char* lds; int tid, lane, wave, vcu, G;
    float* out; unsigned char* ws;
};
#define FIN(i) (A.in[i])
#define XB_TMO      128
#define XB_XCNT(j)  (256  + 64 * (j))
#define XB_XSUB(j)  (1280 + 64 * (j))
#define XB_XGEN(j)  (2304 + 64 * (j))
#define XB_TOP      3328
#define XB_TOPGEN   3392
#define XCD_BAR_WORDS 3456
#define XB_SPIN_CAP (1u << 18)

__device__ __forceinline__ unsigned xb_ld(unsigned* p)              { return __hip_atomic_load(p, __ATOMIC_RELAXED, __HIP_MEMORY_SCOPE_AGENT); }
__device__ __forceinline__ unsigned xb_add(unsigned* p, unsigned v) { return __hip_atomic_fetch_add(p, v, __ATOMIC_RELAXED, __HIP_MEMORY_SCOPE_AGENT); }
__device__ __forceinline__ unsigned xb_xcc_id() { return (unsigned)__builtin_amdgcn_s_getreg((3 << 11) | 20) & 0xFu; }
#define XB_SPIN(cond, bar) do { unsigned _sp = 0; while (cond) { __builtin_amdgcn_s_sleep(1); \
    if ((++_sp & 255u) == 0u) { if (xb_ld(&(bar)[XB_TMO])) break; if (_sp > XB_SPIN_CAP) { atomicAdd(&(bar)[XB_TMO], 1u); break; } } } } while (0)

struct XcdBarrier {
    unsigned* bar; unsigned x;
    volatile LAS unsigned* st;
};

__device__ __forceinline__ XcdBarrier xcd_barrier_post(unsigned* bar, volatile LAS unsigned* st) {
    XcdBarrier b; b.bar = bar; b.x = xb_xcc_id(); b.st = st;
    if (threadIdx.x == 0) (void)xb_add(&bar[XB_XCNT(b.x)], 1u);
    return b;
}
__device__ __forceinline__ void xcd_barrier_complete(unsigned* bar, unsigned x, unsigned& nloc, unsigned& nx) {
    const unsigned G = gridDim.x * gridDim.y * gridDim.z;
    unsigned sum, cnt, mine, sp = 0u;
    for (;;) {
        sum = 0u; cnt = 0u; mine = 0u;
#pragma unroll
        for (unsigned j = 0; j < 16; ++j) { const unsigned c = xb_ld(&bar[XB_XCNT(j)]); sum += c; cnt += (c > 0u) ? 1u : 0u; mine = (j == x) ? c : mine; }
        if (sum == G) break;
        __builtin_amdgcn_s_sleep(1);
        if ((++sp & 255u) == 0u) { if (xb_ld(&bar[XB_TMO])) break; if (sp > XB_SPIN_CAP) { atomicAdd(&bar[XB_TMO], 1u); break; } }
    }
    nloc = mine > 0u ? mine : 1u; nx = cnt > 0u ? cnt : 1u;
}

__device__ __forceinline__ void xcd_barrier(const XcdBarrier& b, const int tid) {
    asm volatile("s_waitcnt vmcnt(0)" ::: "memory");
    __syncthreads();
    if (tid == 0) {
        unsigned* bar = b.bar;
        __builtin_amdgcn_s_waitcnt(0);
        unsigned nloc = b.st[0], nx = b.st[1];
        if (nloc == 0u) { xcd_barrier_complete(bar, b.x, nloc, nx); b.st[0] = nloc; b.st[1] = nx; }
        const unsigned old = xb_add(&bar[XB_XSUB(b.x)], 1u);
        const unsigned gen = old / nloc;
        if (old + 1u == (gen + 1u) * nloc) {
            __builtin_amdgcn_fence(__ATOMIC_RELEASE, "agent");
            asm volatile("s_waitcnt vmcnt(0)" ::: "memory");
            const unsigned og = xb_add(&bar[XB_TOP], 1u);
            const unsigned tg = og / nx;
            if (og + 1u == (tg + 1u) * nx) xb_add(&bar[XB_TOPGEN], 1u);
            else XB_SPIN(xb_ld(&bar[XB_TOPGEN]) == tg, bar);
            __builtin_amdgcn_fence(__ATOMIC_ACQUIRE, "agent");
            xb_add(&bar[XB_XGEN(b.x)], 1u);
            asm volatile("s_waitcnt vmcnt(0)" ::: "memory");
        } else {
            XB_SPIN(xb_ld(&bar[XB_XGEN(b.x)]) == gen, bar);
            __builtin_amdgcn_fence(__ATOMIC_ACQUIRE, "agent");
            asm volatile("s_waitcnt vmcnt(0)" ::: "memory");
        }
    }
    __syncthreads();
}

__device__ __forceinline__ float wave_sum(float v, int lane) {
#pragma unroll
    for (int o = 1; o < 64; o <<= 1) v += pg8::shx(v, lane, o);
    return v;
}
__device__ __forceinline__ unsigned f2bf(float f) { unsigned u = __builtin_bit_cast(unsigned, f); return (u + 0x7fffu + ((u >> 16) & 1u)) >> 16; }
__device__ __forceinline__ unsigned pk2(float lo, float hi) { return f2bf(lo) | (f2bf(hi) << 16); }
__device__ __forceinline__ float silu_f(float x) { return x / (1.f + __expf(-x)); }

__device__ __forceinline__ void transpose_item(const float* W, int ldw, int scol, int K, bf16* WT, int n0, int kb, int lane) {
    const int k0 = 64 * kb + 16 * (lane >> 4); const float* src = W + (size_t)k0 * ldw + scol;
    f32x4 v[16];
#pragma unroll
    for (int i = 0; i < 16; ++i) v[i] = *(const f32x4*)(src + (size_t)i * ldw);
    bf16* dst = WT + (size_t)(n0 + 4 * (lane & 15)) * K + k0;
#pragma unroll
    for (int j = 0; j < 4; ++j) { v4u a, b;
        a.x = pk2(v[0][j], v[1][j]); a.y = pk2(v[2][j], v[3][j]); a.z = pk2(v[4][j], v[5][j]); a.w = pk2(v[6][j], v[7][j]);
        b.x = pk2(v[8][j], v[9][j]); b.y = pk2(v[10][j], v[11][j]); b.z = pk2(v[12][j], v[13][j]); b.w = pk2(v[14][j], v[15][j]);
        *(v4u*)(dst + (size_t)j * K) = a; *(v4u*)(dst + (size_t)j * K + 8) = b; }
}
__device__ __forceinline__ int headcol(int p) { const int bj = p >> 7, k = (p & 127) >> 5; return k * 64 + 32 * bj + (p & 31); }

__device__ __forceinline__ void prologue_transposes(Frame& F, const Args& A, int ncu) {
    const int NGW = ncu * NWAVES + (F.G - ncu) * 4; int gw;
    if (F.vcu < ncu) gw = F.vcu * NWAVES + F.wave; else { if (F.wave >= 4) return; gw = ncu * NWAVES + (F.vcu - ncu) * 4 + F.wave; }
    const int cg4 = 4 * (F.lane & 15);
    constexpr int I_W1 = (D / 64) * (2 * DFF / 64), I_W2 = (DFF / 64) * (D / 64), I_AB = 16 * (1280 / 64), I_WIN = 16 * (1536 / 64), I_WO = 16 * 16, I_GLU = 8 * (1024 / 64);
    constexpr int NIT = 4 * I_W1 + 4 * I_W2 + I_AB + I_WIN + 2 * I_WO + I_GLU;
    for (int it = gw; it < NIT; it += NGW) {
        int r = it;
        if (r < 4 * I_W1) { const int lw = r / I_W1; r %= I_W1; const int nb = r % (2 * DFF / 64), kb = r / (2 * DFF / 64); const int n0 = nb * 64, tile = n0 >> 8, p = n0 & 255;
            const float* W = (p < 128 ? FIN(7) : FIN(8)) + (size_t)lw * D * DFF;
            transpose_item(W, DFF, tile * 128 + (p & 127) + cg4, D, (bf16*)(F.ws + WS_W1T + lw * W1T_ONE), n0, kb, F.lane); continue; }
        r -= 4 * I_W1;
        if (r < 4 * I_W2) { const int lw = r / I_W2; r %= I_W2; const int nb = r % (D / 64), kb = r / (D / 64);
            transpose_item(FIN(9) + (size_t)lw * DFF * D, D, nb * 64 + cg4, DFF, (bf16*)(F.ws + WS_W2T + lw * W2T_ONE), nb * 64, kb, F.lane); continue; }
        r -= 4 * I_W2;
        if (r < I_AB) { const int nb = r % 20, kb = r / 20; const int n0 = nb * 64, tile = n0 >> 8; const int scol = tile < 2 ? n0 + cg4 : tile * 256 + headcol((n0 & 255) + cg4);
            transpose_item(FIN(12), 1280, scol, D, (bf16*)(F.ws + WS_WINAB), n0, kb, F.lane); continue; }
        r -= I_AB;
        if (r < I_WIN) { const int nb = r % 24, kb = r / 24; const int n0 = nb * 64, tile = n0 >> 8; const int scol = tile * 256 + headcol((n0 & 255) + cg4);
            transpose_item(FIN(22), 1536, scol, D, (bf16*)(F.ws + WS_WINW), n0, kb, F.lane); continue; }
        r -= I_WIN;
        if (r < 2 * I_WO) { const int l = r / I_WO; r %= I_WO; const int nb = r % 16, kb = r / 16;
            transpose_item(FIN(10) + (size_t)l * D * D, D, nb * 64 + cg4, D, (bf16*)(F.ws + WS_WOUT) + (size_t)l * D * D, nb * 64, kb, F.lane); continue; }
        r -= 2 * I_WO;
        { const int nb = r % 16, kb = r / 16; const int n0 = nb * 64, tile = n0 >> 8, p = n0 & 255;
            transpose_item(FIN(21) + (p < 128 ? 0 : 512 * 512), 512, tile * 128 + (p & 127) + cg4, 512, (bf16*)(F.ws + WS_GLUT), n0, kb, F.lane); }
    }
}
__device__ __forceinline__ void prologue_mod(Frame& F, const Args& A) {
    LAS float* sl = (LAS float*)F.lds;
    LAS float* red = sl + 3 * 1024;
    for (int i = F.tid; i < 3 * 1024; i += NWAVES * 64) { const int s = i >> 10, k = i & 1023; const float v = s < 2 ? FIN(1)[s * D + k] : FIN(3)[k]; sl[i] = silu_f(v); }
    __syncthreads();
    float* MOD = (float*)(F.ws + WS_MOD); const int cg = F.lane & 15, rs = F.lane >> 4;
    for (int it = F.vcu; it < 2 * (NMOD / 64); it += F.G) {
        const int l = it / (NMOD / 64), cb = it % (NMOD / 64);
        const float* W = FIN(4) + (size_t)l * D * NMOD + cb * 64 + 4 * cg; const int kbeg = F.wave * 128 + rs;
        f32x4 a0 = (f32x4){0.f, 0.f, 0.f, 0.f}, a1 = a0, a2 = a0;
#pragma unroll 16
        for (int i = 0; i < 32; ++i) { const int k = kbeg + 4 * i; const f32x4 w = *(const f32x4*)(W + (size_t)k * NMOD); a0 += w * sl[k]; a1 += w * sl[1024 + k]; a2 += w * sl[2048 + k]; }
#pragma unroll
        for (int j = 0; j < 4; ++j) { a0[j] += pg8::shx(a0[j], F.lane, 16); a0[j] += pg8::shx(a0[j], F.lane, 32); a1[j] += pg8::shx(a1[j], F.lane, 16); a1[j] += pg8::shx(a1[j], F.lane, 32); a2[j] += pg8::shx(a2[j], F.lane, 16); a2[j] += pg8::shx(a2[j], F.lane, 32); }
        if (rs == 0) { *(LAS f32x4*)(red + (F.wave * 3 + 0) * 64 + 4 * cg) = a0; *(LAS f32x4*)(red + (F.wave * 3 + 1) * 64 + 4 * cg) = a1; *(LAS f32x4*)(red + (F.wave * 3 + 2) * 64 + 4 * cg) = a2; }
        __syncthreads();
        if (F.tid < 192) { const int s = F.tid >> 6, c = F.tid & 63; float v = 0.f;
#pragma unroll
            for (int w = 0; w < 8; ++w) v += red[(w * 3 + s) * 64 + c];
            MOD[((size_t)l * 3 + s) * NMOD + cb * 64 + c] = v + FIN(5)[l * NMOD + cb * 64 + c]; }
        __syncthreads();
    }
}
__device__ __forceinline__ void prologue_rope(Frame& F, const Args& A) {
    float* R = (float*)(F.ws + WS_ROPE);
    for (int i = F.tid; i < 128 * 16; i += NWAVES * 64) { const int pos = i >> 4, f = i & 15; const float inv = powf(10000.f, -(float)f / 16.f); const float ang = (float)pos * inv;
        R[pos * 32 + f] = cosf(ang); R[pos * 32 + 16 + f] = sinf(ang); }
}
__device__ __forceinline__ void prologue_s5_item(Frame& F, const Args& A, int g, int dir) {
    LAS float* PW = (LAS float*)F.lds;
    LAS float* BB = PW + 64 * 69 + 4;
    LAS float* CC = BB + 64 * 16 * 2;
    LAS float* BO = CC + 16 * 65 * 2 + 4;
    LAS float* CO = BO + 64 * 16 * 2;
    LAS float* KT = CO + 16 * 65 * 2 + 4;
    LAS float* KD = KT + 32 * 260;
    const float* lam_re = FIN(13); const float* lam_im = FIN(14); const float* b_re = FIN(15); const float* b_im = FIN(16); const float* c_re = FIN(17); const float* c_im = FIN(18); const float* lstep = FIN(19);
    __syncthreads();
    {
    for (int dd = 0; dd < 2; ++dd) {
        const int gi = (dd == 0 ? dir : 1 - dir) * 32 + g; LAS float* Bd = dd == 0 ? BB : BO; LAS float* Cd = dd == 0 ? CC : CO;
        const float dt = expf(lstep[gi]);
        if (dd == 0) for (int i = F.tid; i < 64 * 33; i += NWAVES * 64) { const int p = i / 33, tau = i % 33;
            const float lre = fminf(lam_re[gi * 64 + p], -1e-4f), lim = lam_im[gi * 64 + p]; const float e = expf(lre * dt * (float)tau); float sn, cs; sincosf(lim * dt * (float)tau, &sn, &cs);
            PW[p * 69 + tau * 2] = e * cs; PW[p * 69 + tau * 2 + 1] = e * sn; }
        for (int i = F.tid; i < 64 * 16; i += NWAVES * 64) { const int p = i >> 4, j = i & 15;
            const float lre = fminf(lam_re[gi * 64 + p], -1e-4f), lim = lam_im[gi * 64 + p]; const float er = expf(lre * dt); float sn, cs; sincosf(lim * dt, &sn, &cs);
            const float nr = er * cs - 1.f, ni = er * sn, den = lre * lre + lim * lim; const float fr = (nr * lre + ni * lim) / den, fi = (ni * lre - nr * lim) / den;
            const float xr = b_re[((size_t)gi * 64 + p) * 16 + j], xi = b_im[((size_t)gi * 64 + p) * 16 + j];
            Bd[(p * 16 + j) * 2] = fr * xr - fi * xi; Bd[(p * 16 + j) * 2 + 1] = fr * xi + fi * xr;
            const int ii = j; Cd[(ii * 65 + p) * 2] = c_re[((size_t)gi * 16 + ii) * 64 + p]; Cd[(ii * 65 + p) * 2 + 1] = c_im[((size_t)gi * 16 + ii) * 64 + p]; }
    }
    __syncthreads();
    }
    {
    { const int tau = F.tid >> 4, ib = (F.tid >> 2) & 3, jb = F.tid & 3; float kacc[4][4];
#pragma unroll
      for (int a = 0; a < 4; ++a)
#pragma unroll
          for (int b = 0; b < 4; ++b) kacc[a][b] = 0.f;
#pragma unroll 2
      for (int p = 0; p < 64; ++p) { const float wr_ = PW[p * 69 + tau * 2], wi = PW[p * 69 + tau * 2 + 1]; float zr[4], zi[4];
#pragma unroll
          for (int a = 0; a < 4; ++a) { const float cr = CC[((4 * ib + a) * 65 + p) * 2], ci = CC[((4 * ib + a) * 65 + p) * 2 + 1]; zr[a] = cr * wr_ - ci * wi; zi[a] = cr * wi + ci * wr_; }
#pragma unroll
          for (int b = 0; b < 4; ++b) { const float br = BB[(p * 16 + 4 * jb + b) * 2], bi = BB[(p * 16 + 4 * jb + b) * 2 + 1];
#pragma unroll
              for (int a = 0; a < 4; ++a) kacc[a][b] += zr[a] * br - zi[a] * bi; } }
#pragma unroll
      for (int a = 0; a < 4; ++a)
#pragma unroll
          for (int b = 0; b < 4; ++b) KT[tau * 260 + (4 * ib + a) * 16 + 4 * jb + b] = kacc[a][b]; }
    if (dir == 0) for (int e = F.tid; e < 256; e += NWAVES * 64) { const int i = e >> 4, j = e & 15; float acc = 0.f;
#pragma unroll 2
        for (int p = 0; p < 64; ++p) acc += CO[(i * 65 + p) * 2] * BO[(p * 16 + j) * 2] - CO[(i * 65 + p) * 2 + 1] * BO[(p * 16 + j) * 2 + 1];
        KD[e] = acc + (i == j ? FIN(20)[g * 16 + i] : 0.f); }
    __syncthreads();
    }
    {
    bf16* OUTM = (bf16*)(F.ws + WS_OUTM) + (size_t)g * 512 * S5K; bf16* FS = (bf16*)(F.ws + WS_FS) + (size_t)g * 256 * 512;
    for (int e = F.tid; e < 512 * 32 * 2; e += NWAVES * 64) { const int half = e & 1, s = (e >> 1) & 31, row = e >> 6, t = row >> 4, i = row & 15;
        if (dir == 0 ? (s > t) : (s <= t)) continue;
        const int tau = dir == 0 ? t - s : s - t; f32x4 v0 = *(const LAS f32x4*)(KT + tau * 260 + i * 16 + half * 8), v1 = *(const LAS f32x4*)(KT + tau * 260 + i * 16 + half * 8 + 4);
        if (dir == 0 && s == t) { v0 += *(const LAS f32x4*)(KD + i * 16 + half * 8); v1 += *(const LAS f32x4*)(KD + i * 16 + half * 8 + 4); }
        *(v4u*)(OUTM + (size_t)row * S5K + s * 16 + half * 8) = pg8::pack8(v0, v1); }
    for (int e = F.tid; e < 512 * 16; e += NWAVES * 64) { const int pq = e & 15, row = e >> 4, t = row >> 4, i = row & 15; const int tau = dir == 0 ? t + 1 : S5T - t; float v[8];
#pragma unroll
        for (int q = 0; q < 4; ++q) { const int p = pq * 4 + q; const float cr = CC[(i * 65 + p) * 2], ci = CC[(i * 65 + p) * 2 + 1], wr_ = PW[p * 69 + tau * 2], wi = PW[p * 69 + tau * 2 + 1];
            v[2 * q] = cr * wr_ - ci * wi; v[2 * q + 1] = -(cr * wi + ci * wr_); }
        *(v4u*)(OUTM + (size_t)row * S5K + 512 + dir * 128 + pq * 8) = pg8::pack8((f32x4){v[0], v[1], v[2], v[3]}, (f32x4){v[4], v[5], v[6], v[7]}); }
    for (int e = F.tid; e < 128 * 32 * 2; e += NWAVES * 64) { const int half = e & 1, s = (e >> 1) & 31, rr = e >> 6, p = rr >> 1, ri = rr & 1; const int tau = dir == 0 ? S5T - 1 - s : s;
        const float wr_ = PW[p * 69 + tau * 2], wi = PW[p * 69 + tau * 2 + 1]; float v[8];
#pragma unroll
        for (int q = 0; q < 8; ++q) { const float br = BB[(p * 16 + half * 8 + q) * 2], bi = BB[(p * 16 + half * 8 + q) * 2 + 1]; v[q] = ri == 0 ? (wr_ * br - wi * bi) : (wr_ * bi + wi * br); }
        *(v4u*)(FS + (size_t)(dir * 128 + rr) * 512 + s * 16 + half * 8) = pg8::pack8((f32x4){v[0], v[1], v[2], v[3]}, (f32x4){v[4], v[5], v[6], v[7]}); }
    }
    __syncthreads();
}

__device__ __forceinline__ void norm_phase(Frame& F, const float* xl, const float* xc, const float* gam, const float* MODl, int s, int nrows, int nsplit, const float* pgate, float pcoef) {
    const int gw = F.vcu * NWAVES + F.wave, NGW = F.G * NWAVES; bf16* HN = (bf16*)(F.ws + WS_HN);
    const float* slab = (const float*)(F.ws + WS_REG + R_SLAB); float* XC = (float*)(F.ws + WS_XC);
    for (int r = gw; r < nrows; r += NGW) {
        const float* x = r < NLAT ? xl + (size_t)r * D : xc + (size_t)(r - NLAT) * D;
        const float* m = MODl + (size_t)(r < SEQ ? 0 : (r < NLAT ? 1 : 2)) * NMOD;
        f32x4 v[4]; float ss = 0.f;
#pragma unroll
        for (int j = 0; j < 4; ++j) v[j] = *(const f32x4*)(x + 4 * F.lane + 256 * j);
        if (r >= NLAT && nsplit > 0) {
#pragma unroll
            for (int j = 0; j < 4; ++j) { const int c = 4 * F.lane + 256 * j; f32x4 a = (f32x4){0.f, 0.f, 0.f, 0.f};
                for (int ks = 0; ks < nsplit; ++ks) a += *(const f32x4*)(slab + ((size_t)ks * NCTX + (r - NLAT)) * D + c);
                v[j] += a * (*(const f32x4*)(pgate + c) * pcoef); *(f32x4*)(XC + (size_t)(r - NLAT) * D + c) = v[j]; }
        }
#pragma unroll
        for (int j = 0; j < 4; ++j) ss += (v[j].x * v[j].x + v[j].y * v[j].y) + (v[j].z * v[j].z + v[j].w * v[j].w);
        const float rs = rsqrtf(wave_sum(ss, F.lane) * (1.f / D) + EPS);
#pragma unroll
        for (int j = 0; j < 4; ++j) { const int c = 4 * F.lane + 256 * j;
            const f32x4 gg = *(const f32x4*)(gam + c), sc = *(const f32x4*)(m + (3 * s + 1) * D + c), sh = *(const f32x4*)(m + (3 * s) * D + c);
            const f32x4 y = v[j] * rs * gg * (sc + 1.f) + sh;
            v2u o; o.x = pk2(y.x, y.y); o.y = pk2(y.z, y.w); *(v2u*)(HN + (size_t)r * D + c) = o; }
    }
}
__device__ __forceinline__ void s5_scan_phase(Frame& F, const Args& A) {
    if (F.wave != 0 || F.vcu >= 128) return;
    const int item = F.vcu, g = item & 31, dir = (item >> 5) & 1, b = item >> 6, p = F.lane; const int gi = dir * 32 + g;
    const float dt = expf(FIN(19)[gi]); const float lre = fminf(FIN(13)[gi * 64 + p], -1e-4f), lim = FIN(14)[gi * 64 + p];
    const float e = expf(lre * dt * (float)S5T); float sn, cs; sincosf(lim * dt * (float)S5T, &sn, &cs); const float lr = e * cs, li = e * sn;
    const float* SS = (const float*)(F.ws + WS_REG + R0_SS) + (size_t)g * NCH_PAD * 256 + dir * 128 + 2 * p;
    bf16* UA = (bf16*)(F.ws + WS_REG + R0_UA) + (size_t)g * NCH_PAD * S5K + 512 + dir * 128 + 2 * p;
    constexpr int NC = NCH_CTX / 2, NL = NCH_LAT / 2;
    float hr = 0.f, hi = 0.f;
    auto chunk_of = [&](int n) { return dir == 0 ? (n < NC ? NCH_LAT + b * NC + n : b * NL + (n - NC)) : (n < NC ? NCH_LAT + b * NC + (NC - 1 - n) : b * NL + (NL - 1 - (n - NC))); };
    for (int n0 = 0; n0 < NC + NL; n0 += 8) {
        float sr[8], si[8]; int ch[8];
#pragma unroll
        for (int q = 0; q < 8; ++q) { ch[q] = chunk_of(n0 + q); const float2 sv = *(const float2*)(SS + (size_t)ch[q] * 256); sr[q] = sv.x; si[q] = sv.y; }
#pragma unroll
        for (int q = 0; q < 8; ++q) { *(unsigned*)(UA + (size_t)ch[q] * S5K) = pk2(hr, hi);
            const float nr = lr * hr - li * hi + sr[q], ni = lr * hi + li * hr + si[q]; hr = nr; hi = ni; }
    }
}
__device__ __forceinline__ void attn0_phase(Frame& F) {
    using namespace attn_body;
    const __hip_bfloat16* QB = (const __hip_bfloat16*)(F.ws + WS_REG + R_QB); const __hip_bfloat16* KB = (const __hip_bfloat16*)(F.ws + WS_REG + R0_KB); const __hip_bfloat16* VB = (const __hip_bfloat16*)(F.ws + WS_REG + R0_VB);
    __hip_bfloat16* CAT = (__hip_bfloat16*)(F.ws + WS_REG + R_CAT); char* shm = (char*)F.lds;
    const int upc = 512 / F.G;
    for (int i = 0; i < upc; ++i) { const int uid = F.vcu * upc + i; const int bk = uid >> 7, w = uid & 127; const int b = bk >> 1, kvh = bk & 1, h = kvh * 4 + (w >> 5), qb = w & 31;
        const size_t qrow = (size_t)b * SEQ + qb * 256;
        attn_unit<0, 8>(QB + qrow * 512 + h * 64, 512, KB + (size_t)b * KVROWS * 128 + kvh * 64, VB + (size_t)b * KVROWS * 128 + kvh * 64, 128, CAT + qrow * 1024 + 512 + h * 64, 1024, KVROWS / 64, 0, 0, -INFINITY, shm, F.tid); }
    if ((F.vcu & 15) == 0 && (F.vcu >> 4) < 16) { const int idx = F.vcu >> 4, b = idx >> 3, h = idx & 7, kvh = h >> 2; const size_t qrow = (size_t)NLAT + b * CTX;
        attn_unit<0, 8>(QB + qrow * 512 + h * 64, 512, KB + (size_t)b * KVROWS * 128 + kvh * 64, VB + (size_t)b * KVROWS * 128 + kvh * 64, 128, CAT + qrow * 1024 + 512 + h * 64, 1024, CTX / 64, 0, 0, -INFINITY, shm, F.tid); }
}
__device__ __forceinline__ void attn1_phase(Frame& F, const Args& A) {
    using namespace attn_body;
    const __hip_bfloat16* QB = (const __hip_bfloat16*)(F.ws + WS_REG + R_QB); const __hip_bfloat16* KB = (const __hip_bfloat16*)(F.ws + WS_REG + R1_KB); const __hip_bfloat16* VB = (const __hip_bfloat16*)(F.ws + WS_REG + R1_VB);
    __hip_bfloat16* CAT = (__hip_bfloat16*)(F.ws + WS_REG + R_CAT); char* shm = (char*)F.lds;
    const int upc = 1024 / F.G;
    for (int i = 0; i < upc; ++i) { const int uid = F.vcu * upc + i; const int bk = uid >> 7, w = uid & 127; const int b = bk >> 2, kvh = bk & 3, h = kvh * 4 + (w >> 5), qb = w & 31;
        const int q0 = qb * 256; const int loc0 = q0 - 128 < 0 ? 0 : q0 - 128, loc1 = q0 + 384 > SEQ ? SEQ : q0 + 384; const int NT = 4 + (loc1 - loc0) / 64;
        const size_t qrow = (size_t)b * SEQ + q0;
        attn_unit<1, 8>(QB + qrow * 1024 + h * 64, 1024, KB + (size_t)b * KVROWS * 256 + kvh * 64, VB + (size_t)b * KVROWS * 256 + kvh * 64, 256, CAT + qrow * 1024 + h * 64, 1024, NT, CTX + loc0, loc0 - q0,
                        FIN(23)[h] * 1.4426950408889634f, shm, F.tid); }
}

__device__ __forceinline__ int fresh_tid(int wave_s) { unsigned ones = ~0u; asm volatile("" : "+s"(ones)); int t = wave_s * 64 + (int)__builtin_amdgcn_mbcnt_hi(ones, __builtin_amdgcn_mbcnt_lo(ones, 0u)); asm volatile("" : "+v"(t)); return t; }
#define MKFRAME Frame F; { F.lds = ldsb; F.tid = fresh_tid(wave_s); F.lane = F.tid & 63; F.wave = wave_s; F.G = gridDim.x; const int bx_ = blockIdx.x; F.vcu = (F.G % 8 == 0) ? (bx_ % 8) * (F.G / 8) + bx_ / 8 : bx_; \
    size_t zoff = 0; asm volatile("" : "+s"(zoff)); F.out = A.out + zoff; F.ws = A.ws + zoff; } \
    float* MOD = (float*)(F.ws + WS_MOD); float* XC = (float*)(F.ws + WS_XC); bf16* HN = (bf16*)(F.ws + WS_HN); bf16* ACT = (bf16*)(F.ws + WS_REG + R_ACT); bf16* CAT = (bf16*)(F.ws + WS_REG + R_CAT); \
    LAS unsigned char* ring = F.lds; const int bx = blockIdx.x; (void)MOD; (void)XC; (void)HN; (void)ACT; (void)CAT; (void)ring; (void)bx;
#ifndef MK_REP_MASK
#define MK_REP_MASK 0
#endif
__device__ __forceinline__ void run_op(const Args& A, LAS unsigned char* ldsb, const int wave_s, int op, int p0, int p1, int p2, int rep) {
    using namespace pg8;
    switch (op) {
    case OP_PROLOGUE: { MKFRAME
        prologue_mod(F, A);
        if (F.vcu == F.G - 65) prologue_rope(F, A);
        prologue_transposes(F, A, F.G - 64);
        if (F.vcu >= F.G - 64) { __syncthreads(); const int item = F.G - 1 - F.vcu; prologue_s5_item(F, A, item & 31, item >> 5); }
    } break;
    case OP_NORM: { MKFRAME const int l = p0, s = p1, nrows = p2 & 0xfffff, first = (p2 >> 20) & 1, cfirst = (p2 >> 21) & 1, nsplit = rep ? 0 : ((p2 >> 22) & 15), pone = (p2 >> 26) & 1, pg = (p2 >> 27) & 7;
        norm_phase(F, first ? FIN(0) : F.out, (cfirst && !(rep && ((p2 >> 22) & 15))) ? FIN(2) : XC, FIN(6) + ((size_t)l * 3 + s) * D, MOD + (size_t)l * 3 * NMOD, s, nrows,
                   nsplit, MOD + (size_t)(pg / 3) * 3 * NMOD + 2 * NMOD + (3 * (pg % 3) + 2) * D, pone ? 1.0f : 0.5f);
    } break;
    case OP_FFNA: { MKFRAME Gemm g{HN, (const bf16*)(F.ws + WS_W1T + p0 * W1T_ONE), D, D, D}; TileOrder S; S.init(p1, 2 * DFF / 256, F.G, bx, 0);
        EpiSwiglu E{ACT, DFF}; gemm_phase<EpiSwiglu, TileOrder, true>(ring, F.tid, g, S, E);
    } break;
    case OP_FFNB: case OP_WOUT: { MKFRAME
        const bool ffn = op == OP_FFNB; const int l = ffn ? (p1 >> 4) : p0, s = ffn ? (p1 & 15) : 1, first = (ffn && !rep) ? ((p2 >> 20) & 1) : 0, nsplit = ffn ? ((p2 >> 22) & 15) : (p2 & 15);
        const bf16* Aop = ffn ? ACT : CAT; const bf16* Bop = ffn ? (const bf16*)(F.ws + WS_W2T + p0 * W2T_ONE) : (const bf16*)(F.ws + WS_WOUT) + (size_t)l * D * D; const int Kfull = ffn ? DFF : D;
        { Gemm g{Aop, Bop, Kfull, Kfull, Kfull}; TileOrder S; S.init(NLAT / 256, D / 256, F.G, bx, 0);
          EpiResid E{first ? FIN(0) : F.out, XC, F.out, XC, MOD + (size_t)l * 3 * NMOD + (3 * s + 2) * D, (ffn ? 0.5f : 1.0f) * (((MK_REP_MASK >> op) & 1) ? 0.5f : 1.0f)}; gemm_phase<EpiResid, TileOrder, true>(ring, F.tid, g, S, E); }
        if (nsplit > 0) { Gemm g{Aop, Bop, Kfull, Kfull, 256}; SplitOrder S{nsplit, F.G, F.vcu}; EpiSlab E{(float*)(F.ws + WS_REG + R_SLAB)}; gemm_phase<EpiSlab, SplitOrder, true>(ring, F.tid, g, S, E); }
    } break;
    case OP_INAB: { MKFRAME Gemm g{HN, (const bf16*)(F.ws + WS_WINAB), D, D, D}; TileOrder S; S.init(MALL / 256, 5, F.G, bx, 0);
        EpiIn E{0, (bf16*)(F.ws + WS_REG + R0_UA), (bf16*)(F.ws + WS_REG + R_QB), 512, (bf16*)(F.ws + WS_REG + R0_KB), (bf16*)(F.ws + WS_REG + R0_VB), 128, FIN(11), (const float*)(F.ws + WS_ROPE)};
        gemm_phase<EpiIn, TileOrder, true>(ring, F.tid, g, S, E);
    } break;
    case OP_INWIN: { MKFRAME Gemm g{HN, (const bf16*)(F.ws + WS_WINW), D, D, D}; TileOrder S; S.init(MALL / 256, 6, F.G, bx, 0);
        EpiIn E{1, nullptr, (bf16*)(F.ws + WS_REG + R_QB), 1024, (bf16*)(F.ws + WS_REG + R1_KB), (bf16*)(F.ws + WS_REG + R1_VB), 256, FIN(11) + 2 * HD, (const float*)(F.ws + WS_ROPE)};
        gemm_phase<EpiIn, TileOrder, true>(ring, F.tid, g, S, E);
    } break;
    case OP_S5STATE: { MKFRAME Gemm g{(const bf16*)(F.ws + WS_REG + R0_UA), (const bf16*)(F.ws + WS_FS), S5K, 512, 512}; GroupOrder S{3, 1, 3, F.G, F.vcu};
        EpiS5State E{(float*)(F.ws + WS_REG + R0_SS)}; gemm_phase<EpiS5State, GroupOrder, true>(ring, F.tid, g, S, E);
    } break;
    case OP_S5SCAN: { MKFRAME s5_scan_phase(F, A); } break;
    case OP_S5OUT: { MKFRAME Gemm g{(const bf16*)(F.ws + WS_REG + R0_UA), (const bf16*)(F.ws + WS_OUTM), S5K, S5K, S5K}; GroupOrder S{3, 2, 3, F.G, F.vcu};
        EpiS5Out E{(bf16*)(F.ws + WS_REG + R0_G5)}; gemm_phase<EpiS5Out, GroupOrder, true>(ring, F.tid, g, S, E);
    } break;
    case OP_GLU: { MKFRAME Gemm g{(const bf16*)(F.ws + WS_REG + R0_G5), (const bf16*)(F.ws + WS_GLUT), 512, 512, 512}; TileOrder S; S.init(MALL / 256, 4, F.G, bx, 0);
        EpiGlu E{CAT, 1024}; gemm_phase<EpiGlu, TileOrder, true>(ring, F.tid, g, S, E);
    } break;
    case OP_ATTN0: { MKFRAME attn0_phase(F); } break;
    case OP_ATTN1: { MKFRAME attn1_phase(F, A); } break;
    default: break;
    }
}

#define T66 (MALL / 256)
#define T64 (NLAT / 256)
#define FIRST (1 << 20)
#define CFIRST (1 << 21)
#define NSPLIT(n) ((n) << 22)
#define PEND(n, one, pg) (((n) << 22) | ((one) << 26) | ((pg) << 27))
__device__ const int PROGRAM[][4] = {
    {OP_PROLOGUE, 0, 0, 0},
    {OP_NORM, 0, 0, MALL | FIRST | CFIRST}, {OP_FFNA, 0, T66, 0}, {OP_FFNB, 0, 0 * 16 + 0, FIRST | NSPLIT(11)},
    {OP_NORM, 0, 1, MALL | CFIRST | PEND(11, 0, 0)}, {OP_INAB, 0, 0, 0},
    {OP_S5STATE, 0, 0, 0}, {OP_S5SCAN, 0, 0, 0}, {OP_S5OUT, 0, 0, 0}, {OP_GLU, 0, 0, 0}, {OP_ATTN0, 0, 0, 0},
    {OP_WOUT, 0, 0, 4},
    {OP_NORM, 0, 2, MALL | PEND(4, 1, 1)}, {OP_FFNA, 1, T66, 0}, {OP_FFNB, 1, 0 * 16 + 2, NSPLIT(11)},
    {OP_NORM, 1, 0, MALL | PEND(11, 0, 2)}, {OP_FFNA, 2, T66, 0}, {OP_FFNB, 2, 1 * 16 + 0, NSPLIT(11)},
    {OP_NORM, 1, 1, MALL | PEND(11, 0, 3)}, {OP_INWIN, 0, 0, 0}, {OP_ATTN1, 0, 0, 0},
    {OP_WOUT, 1, 0, 0},
    {OP_NORM, 1, 2, NLAT}, {OP_FFNA, 3, T64, 0}, {OP_FFNB, 3, 1 * 16 + 2, 0},
};
constexpr int N_OPS = sizeof(PROGRAM) / sizeof(PROGRAM[0]);

__global__ void __launch_bounds__(NWAVES * 64, 2) mega(Args A) {
    extern __shared__ __attribute__((aligned(16))) unsigned char lds_raw[];
    for (int u = threadIdx.x; u < (LDS_BYTES - LDSCTL_OFF) / 4; u += NWAVES * 64) ((LAS unsigned*)((LAS unsigned char*)lds_raw + LDSCTL_OFF))[u] = 0u;
    __syncthreads();
    XcdBarrier bar = xcd_barrier_post((unsigned*)(A.ws + WS_CTL) + CW_BAR, (volatile LAS unsigned*)((LAS unsigned char*)lds_raw + MISC_OFF) + 8);
    const int wave_s = __builtin_amdgcn_readfirstlane(threadIdx.x >> 6);
    for (int k = A.k_lo; k < A.k_hi; ++k) {
        const int op = __builtin_amdgcn_readfirstlane(PROGRAM[k][0]), p0 = __builtin_amdgcn_readfirstlane(PROGRAM[k][1]), p1 = __builtin_amdgcn_readfirstlane(PROGRAM[k][2]), p2 = __builtin_amdgcn_readfirstlane(PROGRAM[k][3]);
        run_op(A, (LAS unsigned char*)lds_raw, wave_s, op, p0, p1, p2, 0);
#if MK_REP_MASK
        if ((MK_REP_MASK >> op) & 1) { xcd_barrier(bar, fresh_tid(wave_s)); run_op(A, (LAS unsigned char*)lds_raw, wave_s, op, p0, p1, p2, 1); }
#endif
#if defined(MK_EXTRA_BAR)
        for (int e = 0; e < MK_EXTRA_BAR; ++e) xcd_barrier(bar, fresh_tid(wave_s));
#endif
        if (k + 1 < A.k_hi) {
            if (k == A.k_lo) { __syncthreads(); cg::this_grid().sync(); }
            else xcd_barrier(bar, fresh_tid(wave_s));
        }
    }
}

#ifndef MK_ONE_LAUNCH
#define MK_ONE_LAUNCH 0
#endif
extern "C" void kernel_launch(void* const* d_in, const int* in_sizes, int n_in, void* d_out, int out_size, void* d_ws, size_t ws_size, hipStream_t stream) {
    static int grid = 0;
    if (grid == 0) {
        int dev = 0, cus = 0;
        if (hipGetDevice(&dev) != hipSuccess || hipDeviceGetAttribute(&cus, hipDeviceAttributeMultiprocessorCount, dev) != hipSuccess) { grid = -1; return; }
        if (hipFuncSetAttribute((const void*)mega, hipFuncAttributeMaxDynamicSharedMemorySize, LDS_BYTES) != hipSuccess) { fprintf(stderr, "hipFuncSetAttribute failed\n"); grid = -1; return; }
        int per_cu = 0; (void)hipOccupancyMaxActiveBlocksPerMultiprocessor(&per_cu, (const void*)mega, NWAVES * 64, LDS_BYTES); (void)hipGetLastError();
        if (cus < 256 || per_cu < 1 || n_in != 24 || ws_size < WS_END) { fprintf(stderr, "kernel_launch: unsupported device/workspace (cus %d, per_cu %d, ws %zu need %zu)\n", cus, per_cu, ws_size, (size_t)WS_END); grid = -1; return; }
        grid = 256;
    }
    if (grid < 0) return;
    if (hipMemsetAsync((char*)d_ws + WS_CTL, 0, CTL_BYTES, stream) != hipSuccess) { fprintf(stderr, "memset failed\n"); return; }
    Args a{};
    for (int i = 0; i < 24; ++i) a.in[i] = (const float*)d_in[i];
    a.out = (float*)d_out; a.ws = (unsigned char*)d_ws;
#if MK_ONE_LAUNCH
    a.k_lo = 0; a.k_hi = N_OPS;
    void* kargs[] = {&a};
    hipError_t e = hipLaunchCooperativeKernel((const void*)mega, dim3(grid), dim3(NWAVES * 64), kargs, LDS_BYTES, stream);
    if (e != hipSuccess) fprintf(stderr, "cooperative launch failed: %s\n", hipGetErrorString(e));
#else
    for (int k = 0; k < N_OPS; ++k) { a.k_lo = k; a.k_hi = k + 1; hipLaunchKernelGGL(mega, dim3(grid), dim3(NWAVES * 64), LDS_BYTES, stream, a); }
#endif
}
```
